# Optimizing an MI355X kernel written in HIP

```python
import jax, jax.numpy as jnp
from jax import lax
import numpy as np

D_MODEL = 2048
BATCH = 1
SEQ = 8192
DEPTH = 2

CONV_DIM = D_MODEL // 2
CONV_WIDTH = 31
NSA_HEADS = 16
NSA_HEAD_DIM = 64
NSA_KV_HEADS = 4
NSA_GROUP = NSA_HEADS // NSA_KV_HEADS
N_BRANCH = 3
CMP_LEN = 32
CMP_STRIDE = 16
CMP_HIDDEN = 2 * NSA_HEAD_DIM
SEL_LEN = 64
SEL_TOPK = 16
WINDOW = 512
Q_BLOCK = 128
FORCE_BONUS = 1e3
NEG_INF = -1e30
POOL_WINDOWS = (2, 4, 8, 16)
POOL_GROUPS = len(POOL_WINDOWS)
POOL_DIM = D_MODEL // POOL_GROUPS
D_FF = 4 * D_MODEL
EPS = 1e-6

Q_COLS = NSA_HEADS * NSA_HEAD_DIM
KV_COLS = NSA_KV_HEADS * NSA_HEAD_DIM
GATE_COLS = NSA_HEADS * N_BRANCH
IN_COLS = 2 * CONV_DIM + Q_COLS + 2 * N_BRANCH * KV_COLS + GATE_COLS
N_EVEN = (DEPTH + 1) // 2
N_ODD = DEPTH // 2

kernel_name = "hybrid_conv_nsa_pool_block"


def rmsnorm(x, g):
    xf = x.astype(jnp.float32)
    r = lax.rsqrt(jnp.mean(xf * xf, axis=-1, keepdims=True) + EPS)
    return (xf * r * g.astype(jnp.float32)).astype(x.dtype)


def layernorm(x, g, b):
    xf = x.astype(jnp.float32)
    mu = jnp.mean(xf, axis=-1, keepdims=True)
    xc = xf - mu
    var = jnp.mean(xc * xc, axis=-1, keepdims=True)
    y = xc * lax.rsqrt(var + EPS) * g.astype(jnp.float32) + b.astype(jnp.float32)
    return y.astype(x.dtype)


def masked_softmax(s, mask):
    s = jnp.where(mask, s.astype(jnp.float32), NEG_INF)
    p = jax.nn.softmax(s, axis=-1)
    return jnp.where(mask, p, 0.0)


def causal_depthwise_conv(u, w, b):
    C = u.shape[-1]
    lhs = jnp.pad(u, ((0, 0), (CONV_WIDTH - 1, 0), (0, 0)))
    out = lax.conv_general_dilated(
        lhs, w[:, None, :].astype(u.dtype), window_strides=(1,), padding='VALID',
        dimension_numbers=('NWC', 'WIO', 'NWC'), feature_group_count=C)
    return out + b


def compress_blocks(k, pos, w1, w2):
    B, S, G, dh = k.shape
    ch = k.reshape(B, S // CMP_STRIDE, CMP_STRIDE, G, dh)
    blk = jnp.concatenate([ch[:, :-1], ch[:, 1:]], axis=2)
    blk = blk + pos[None, None, :, None, :]
    nc = blk.shape[1]
    blk = blk.transpose(0, 1, 3, 2, 4).reshape(B, nc, G, CMP_LEN * dh)
    h = jax.nn.silu(blk @ w1)
    return h @ w2


def nsa(q, k_c, v_c, k_s, v_s, k_w, v_w, gates, pos_k, pos_v, kw1, kw2, vw1, vw2):
    B, S, H, dh = q.shape
    G, R = NSA_KV_HEADS, NSA_GROUP
    scale = dh ** -0.5
    q = q.reshape(B, S, G, R, dh)
    gates = gates.reshape(B, S, G, R, N_BRANCH)

    kc = compress_blocks(k_c, pos_k, kw1, kw2)
    vc = compress_blocks(v_c, pos_v, vw1, vw2)
    nc = kc.shape[1]
    cmp_start = jnp.arange(nc) * CMP_STRIDE
    cmp_end = cmp_start + CMP_LEN - 1

    n_sel = S // SEL_LEN
    topk = min(SEL_TOPK, n_sel)
    sel_start = jnp.arange(n_sel) * SEL_LEN
    overlap = ((cmp_start[:, None] <= sel_start[None, :] + SEL_LEN - 1)
               & (cmp_end[:, None] >= sel_start[None, :])).astype(jnp.float32)
    ks_blk = k_s.reshape(B, n_sel, SEL_LEN, G, dh).transpose(0, 3, 1, 2, 4)
    vs_blk = v_s.reshape(B, n_sel, SEL_LEN, G, dh).transpose(0, 3, 1, 2, 4)
    gather = jax.vmap(jax.vmap(lambda blk, i: blk[i]))

    kw_pad = jnp.pad(k_w, ((0, 0), (WINDOW, 0), (0, 0), (0, 0)))
    vw_pad = jnp.pad(v_w, ((0, 0), (WINDOW, 0), (0, 0), (0, 0)))
    sel_j = jnp.arange(n_sel)
    sel_off = jnp.arange(SEL_LEN)
    win_off = jnp.arange(WINDOW + Q_BLOCK)

    def block_fn(bi):
        s0 = bi * Q_BLOCK
        qb = lax.dynamic_slice_in_dim(q, s0, Q_BLOCK, axis=1)
        gb = lax.dynamic_slice_in_dim(gates, s0, Q_BLOCK, axis=1)
        t = s0 + jnp.arange(Q_BLOCK)

        sc = jnp.einsum('bqgrd,bngd->bgrqn', qb, kc) * scale
        pc = masked_softmax(sc, cmp_end[None, :] <= t[:, None])
        oc = jnp.einsum('bgrqn,bngd->bqgrd', pc.astype(vc.dtype), vc)

        imp = jnp.einsum('bgrqn,nj->bgqj', pc, overlap)
        cur = t // SEL_LEN
        forced = (sel_j[None, :] == 0) | (sel_j[None, :] == cur[:, None]) | (sel_j[None, :] == cur[:, None] - 1)
        future = sel_j[None, :] > cur[:, None]
        imp = jnp.where(future, NEG_INF, imp + jnp.where(forced, FORCE_BONUS, 0.0))
        _, idx = lax.top_k(imp, topk)
        ks_sel = gather(ks_blk, idx)
        vs_sel = gather(vs_blk, idx)
        ss = jnp.einsum('bqgrd,bgqkld->bgrqkl', qb, ks_sel) * scale
        kpos = idx[..., None] * SEL_LEN + sel_off
        ms = (kpos <= t[:, None, None])[:, :, None]
        ps = masked_softmax(ss.reshape(B, G, R, Q_BLOCK, topk * SEL_LEN),
                            ms.reshape(B, G, 1, Q_BLOCK, topk * SEL_LEN))
        ps = ps.reshape(B, G, R, Q_BLOCK, topk, SEL_LEN).astype(vs_sel.dtype)
        os_ = jnp.einsum('bgrqkl,bgqkld->bqgrd', ps, vs_sel)

        kwb = lax.dynamic_slice_in_dim(kw_pad, s0, WINDOW + Q_BLOCK, axis=1)
        vwb = lax.dynamic_slice_in_dim(vw_pad, s0, WINDOW + Q_BLOCK, axis=1)
        wpos = s0 - WINDOW + win_off
        mw = ((wpos[None, :] <= t[:, None]) & (wpos[None, :] > t[:, None] - WINDOW)
              & (wpos[None, :] >= 0))
        sw = jnp.einsum('bqgrd,bkgd->bgrqk', qb, kwb) * scale
        pw = masked_softmax(sw, mw).astype(vwb.dtype)
        ow = jnp.einsum('bgrqk,bkgd->bqgrd', pw, vwb)

        return gb[..., 0:1] * oc + gb[..., 1:2] * os_ + gb[..., 2:3] * ow

    out = lax.map(block_fn, jnp.arange(S // Q_BLOCK))
    out = out.transpose(1, 0, 2, 3, 4, 5).reshape(B, S, H * dh)
    return out


def even_mixer(x, g, w_in, w_out, conv_w, conv_b, ln_g, ln_b,
               pos_k, pos_v, kw1, kw2, vw1, vw2):
    B, S, _ = x.shape
    xn = rmsnorm(x, g)
    proj = xn @ w_in
    sizes = [CONV_DIM, CONV_DIM, Q_COLS] + [KV_COLS] * (2 * N_BRANCH) + [GATE_COLS]
    cuts = list(np.cumsum(sizes)[:-1])
    a, gt, q, k_c, v_c, k_s, v_s, k_w, v_w, gl = jnp.split(proj, cuts, axis=-1)
    c = a * jax.nn.sigmoid(gt)
    c = causal_depthwise_conv(c, conv_w, conv_b)
    c = jax.nn.silu(layernorm(c, ln_g, ln_b))
    kv = lambda t_: t_.reshape(B, S, NSA_KV_HEADS, NSA_HEAD_DIM)
    o = nsa(q.reshape(B, S, NSA_HEADS, NSA_HEAD_DIM), kv(k_c), kv(v_c), kv(k_s), kv(v_s),
            kv(k_w), kv(v_w), jax.nn.sigmoid(gl.reshape(B, S, NSA_HEADS, N_BRANCH)),
            pos_k, pos_v, kw1, kw2, vw1, vw2)
    return jnp.concatenate([c, o], axis=-1) @ w_out


def odd_mixer(x, g, pool_w, pool_scale):
    B, S, _ = x.shape
    xn = rmsnorm(x, g).astype(jnp.float32)
    cs = jnp.cumsum(xn, axis=1)
    pos1 = jnp.arange(1, S + 1)
    parts = []
    for gi, w in enumerate(POOL_WINDOWS):
        sl = slice(gi * POOL_DIM, (gi + 1) * POOL_DIM)
        csg = cs[..., sl]
        shifted = jnp.pad(csg, ((0, 0), (w, 0), (0, 0)))[:, :S]
        cnt = jnp.minimum(pos1, w).astype(jnp.float32)
        parts.append((csg - shifted) / cnt[None, :, None] - xn[..., sl])
    p = jnp.stack(parts, axis=2).astype(x.dtype)
    y = jnp.einsum('bsgp,gpo->bsgo', p, pool_w).reshape(B, S, D_MODEL)
    return y * pool_scale


def mlp(x, g, w1, w2):
    h = rmsnorm(x, g) @ w1
    h = jnp.square(jax.nn.relu(h))
    return h @ w2


def setup_inputs(seed: int = 0) -> dict:
    key = jax.random.key(seed)
    ks = jax.random.split(key, 24)
    nrm = lambda k, shape, s: jax.random.normal(k, shape, jnp.float32) * s
    dh = NSA_HEAD_DIM
    return {
        "x": nrm(ks[0], (BATCH, SEQ, D_MODEL), 1.0),
        "mix_norm": 1.0 + nrm(ks[1], (DEPTH, D_MODEL), 0.02),
        "mlp_norm": 1.0 + nrm(ks[2], (DEPTH, D_MODEL), 0.02),
        "w_mlp_in": nrm(ks[3], (DEPTH, D_MODEL, D_FF), D_MODEL ** -0.5),
        "w_mlp_out": nrm(ks[4], (DEPTH, D_FF, D_MODEL), D_FF ** -0.5),
        "w_in": nrm(ks[5], (N_EVEN, D_MODEL, IN_COLS), D_MODEL ** -0.5),
        "w_out": nrm(ks[6], (N_EVEN, D_MODEL, D_MODEL), D_MODEL ** -0.5),
        "conv_w": nrm(ks[7], (N_EVEN, CONV_WIDTH, CONV_DIM), CONV_WIDTH ** -0.5),
        "conv_b": nrm(ks[8], (N_EVEN, CONV_DIM), 0.01),
        "conv_ln_g": 1.0 + nrm(ks[9], (N_EVEN, CONV_DIM), 0.02),
        "conv_ln_b": nrm(ks[10], (N_EVEN, CONV_DIM), 0.01),
        "cmp_pos_k": nrm(ks[11], (N_EVEN, CMP_LEN, dh), 0.1),
        "cmp_pos_v": nrm(ks[12], (N_EVEN, CMP_LEN, dh), 0.1),
        "cmp_k_w1": nrm(ks[13], (N_EVEN, CMP_LEN * dh, CMP_HIDDEN), (CMP_LEN * dh) ** -0.5),
        "cmp_k_w2": nrm(ks[14], (N_EVEN, CMP_HIDDEN, dh), CMP_HIDDEN ** -0.5),
        "cmp_v_w1": nrm(ks[15], (N_EVEN, CMP_LEN * dh, CMP_HIDDEN), (CMP_LEN * dh) ** -0.5),
        "cmp_v_w2": nrm(ks[16], (N_EVEN, CMP_HIDDEN, dh), CMP_HIDDEN ** -0.5),
        "pool_w": nrm(ks[17], (N_ODD, POOL_GROUPS, POOL_DIM, POOL_DIM), POOL_DIM ** -0.5),
        "pool_scale": 1.0 + nrm(ks[18], (N_ODD, D_MODEL), 0.02),
        "final_norm": 1.0 + nrm(ks[19], (D_MODEL,), 0.02),
    }


def reference(x, mix_norm, mlp_norm, w_mlp_in, w_mlp_out, w_in, w_out, conv_w, conv_b,
              conv_ln_g, conv_ln_b, cmp_pos_k, cmp_pos_v, cmp_k_w1, cmp_k_w2,
              cmp_v_w1, cmp_v_w2, pool_w, pool_scale, final_norm):
    for layer in range(DEPTH):
        i = layer // 2
        if layer % 2 == 0:
            x = x + even_mixer(x, mix_norm[layer], w_in[i], w_out[i], conv_w[i], conv_b[i],
                               conv_ln_g[i], conv_ln_b[i], cmp_pos_k[i], cmp_pos_v[i],
                               cmp_k_w1[i], cmp_k_w2[i], cmp_v_w1[i], cmp_v_w2[i])
        else:
            x = x + odd_mixer(x, mix_norm[layer], pool_w[i], pool_scale[i])
        x = x + mlp(x, mlp_norm[layer], w_mlp_in[layer], w_mlp_out[layer])
    return rmsnorm(x, final_norm)
```

```cpp
#include <hip/hip_runtime.h>
#include <hip/hip_cooperative_groups.h>
#include <cstdio>
#include <cstdint>
namespace cg = cooperative_groups;

#ifndef MK_LAUNCHES
#define MK_LAUNCHES 1
#endif

#define LAS __attribute__((address_space(3)))
typedef unsigned short bf16_t;
typedef short bf16x8 __attribute__((ext_vector_type(8)));
typedef float f32x4 __attribute__((ext_vector_type(4)));
typedef float f32x2 __attribute__((ext_vector_type(2)));
typedef unsigned u32x4 __attribute__((ext_vector_type(4)));
typedef unsigned u32x2 __attribute__((ext_vector_type(2)));
typedef short v4i16_t __attribute__((ext_vector_type(4)));

typedef __bf16 bf16x2_t __attribute__((ext_vector_type(2)));
__device__ __forceinline__ unsigned cvt_pk_bf16(float lo, float hi) { f32x2 v = {lo, hi}; bf16x2_t b = __builtin_convertvector(v, bf16x2_t); return __builtin_bit_cast(unsigned, b); }
__device__ __forceinline__ float bf2f(unsigned short b) { return __uint_as_float(((unsigned)b) << 16); }
__device__ __forceinline__ float bflo(unsigned w) { return __uint_as_float(w << 16); }
__device__ __forceinline__ float bfhi(unsigned w) { return __uint_as_float(w & 0xffff0000u); }
__device__ __forceinline__ float fexp2(float x) { return __builtin_amdgcn_exp2f(x); }
__device__ __forceinline__ float sigmoidf_(float x) { return 1.0f / (1.0f + __expf(-x)); }

constexpr int SEQ = 8192, DM = 2048, DFF = 8192, LDP = 4864  , INC = 4656;
constexpr int OFF_A = 0, OFF_GT = 1024, OFF_Q = 2048, OFF_KC = 3072, OFF_VC = 3328, OFF_KS = 3584, OFF_VS = 3840, OFF_KW = 4096, OFF_VW = 4352, OFF_GL = 4608;
constexpr float EPS = 1e-6f;

constexpr size_t MiB = 1u << 20;
constexpr size_t WS_SSQ = 0;
constexpr size_t WS_BAR = 256 * 1024;
constexpr size_t WS_CW1K = 1 * MiB, WS_CW1V = 1 * MiB + 512 * 1024, WS_CW2K = 2 * MiB, WS_CW2V = 2 * MiB + 64 * 1024;
constexpr size_t WS_KC = 3 * MiB, WS_VCT = 3 * MiB + 512 * 1024;
constexpr size_t WS_POOLT = 4 * MiB, WS_VTS = 6 * MiB, WS_VTW = 10 * MiB, WS_WOUT = 14 * MiB, WS_WIN = 22 * MiB;
constexpr size_t WS_W1 = 42 * MiB, WS_W2 = 106 * MiB, WS_XB = 170 * MiB, WS_CO = 202 * MiB, WS_PROJ = 234 * MiB, WS_H = 310 * MiB, WS_END = 438 * MiB;

namespace pg8 {
constexpr int BM = 256, BK = 64, HALF = 128, HTB = HALF * BK * 2, STAGE_BYTES = 8 * HTB, NXCD = 8, WGM = 8;
__host__ __device__ __forceinline__ int lds_byte(int r, int c) { const int st = (r >> 4) * 2 + (c >> 5), rr = r & 15, cc = c & 31, ob = rr * 64 + cc * 2; return st * 1024 + (ob ^ (((ob >> 9) & 1) << 5)); }
__host__ __device__ __forceinline__ void stage_rc(int b, int& R, int& C) { const int st = b / 1024, sb = b % 1024, swz = sb ^ (((sb >> 9) & 1) << 5); R = (st >> 1) * 16 + swz / 64; C = (st & 1) * 32 + (swz % 64) / 2; }
__host__ __device__ __forceinline__ int perm32(int rho) { const int n = rho >> 4, i = rho & 15; return 8 * (i >> 2) + 4 * n + (i & 3); }
struct Unit { int pm, pn; };
struct Gemm { const bf16_t* A; const bf16_t* Bt; int lda, ldb, K, a_pn_shift, a_pn_bytes; };
struct StaticOrder {
    int nM, nN, nwg, G, c;
    __host__ __device__ void init(int M, int N, int G_, int c_) { nM = M / BM; nN = N / BM; nwg = nM * nN; G = G_; c = c_; }
    __host__ __device__ bool next(int i, Unit& u) const {
        const long L = (long)i * G + c; if (L >= nwg) return false;
        int wgid = (int)L; { const int q = nwg / NXCD, r = nwg % NXCD, xcd = wgid % NXCD, off = wgid / NXCD; wgid = (xcd < r ? xcd * (q + 1) : r * (q + 1) + (xcd - r) * q) + off; }
        const int nig = WGM * nN, gid = wgid / nig, fm = gid * WGM, gsz = (nM - fm) < WGM ? (nM - fm) : WGM;
        u.pm = fm + ((wgid % nig) % gsz); u.pn = (wgid % nig) / gsz; return true;
    }
};
struct EpiBf16 {
    static constexpr bool PERM = true, AFTER_DRAIN = false;
    bf16_t* O; int ldc; int glu_tiles; const float* ssq;
    __device__ __forceinline__ void operator()(const f32x4 (&acc)[2][2][4][2], const Unit& u, int wr, int wc, int fr, int fq) const {
        const int row0 = u.pm * BM + wr * 64 + fr, col0 = u.pn * BM + wc * 32 + 8 * fq;
        if (u.pn < glu_tiles) {
#pragma unroll
            for (int ai = 0; ai < 2; ++ai)
#pragma unroll
                for (int m = 0; m < 4; ++m) { const int row = row0 + ai * HALF + m * 16; bf16_t* rowp = O + (size_t)row * ldc + col0; const float r = __builtin_amdgcn_rsqf(ssq[row] * (1.0f / 2048.0f) + EPS);
                    f32x4 v0 = acc[ai][0][m][0] * r, v1 = acc[ai][0][m][1] * r; const f32x4 g0 = acc[ai][1][m][0] * r, g1 = acc[ai][1][m][1] * r;
#pragma unroll
                    for (int e = 0; e < 4; ++e) { v0[e] *= sigmoidf_(g0[e]); v1[e] *= sigmoidf_(g1[e]); }
                    u32x4 w; w.x = cvt_pk_bf16(v0[0], v0[1]); w.y = cvt_pk_bf16(v0[2], v0[3]); w.z = cvt_pk_bf16(v1[0], v1[1]); w.w = cvt_pk_bf16(v1[2], v1[3]);
                    *(u32x4*)rowp = w; }
            return;
        }
#pragma unroll
        for (int ai = 0; ai < 2; ++ai)
#pragma unroll
            for (int m = 0; m < 4; ++m) { const int row = row0 + ai * HALF + m * 16; bf16_t* rowp = O + (size_t)row * ldc + col0; const float r = __builtin_amdgcn_rsqf(ssq[row] * (1.0f / 2048.0f) + EPS);
#pragma unroll
                for (int bj = 0; bj < 2; ++bj) { const f32x4 v0 = acc[ai][bj][m][0] * r, v1 = acc[ai][bj][m][1] * r;
                    u32x4 w; w.x = cvt_pk_bf16(v0[0], v0[1]); w.y = cvt_pk_bf16(v0[2], v0[3]); w.z = cvt_pk_bf16(v1[0], v1[1]); w.w = cvt_pk_bf16(v1[2], v1[3]);
                    *(u32x4*)(rowp + bj * HALF) = w; } }
    }
};
struct EpiRelu2 {
    static constexpr bool PERM = true, AFTER_DRAIN = false;
    bf16_t* O; int ldc; const float* ssq;
    __device__ __forceinline__ void operator()(const f32x4 (&acc)[2][2][4][2], const Unit& u, int wr, int wc, int fr, int fq) const {
        const int row0 = u.pm * BM + wr * 64 + fr, col0 = u.pn * BM + wc * 32 + 8 * fq;
#pragma unroll
        for (int ai = 0; ai < 2; ++ai)
#pragma unroll
            for (int m = 0; m < 4; ++m) { const int row = row0 + ai * HALF + m * 16; bf16_t* rowp = O + (size_t)row * ldc + col0;
                const float r = __builtin_amdgcn_rsqf(ssq[row] * (1.0f / 2048.0f) + EPS);
#pragma unroll
                for (int bj = 0; bj < 2; ++bj) { f32x4 v0 = acc[ai][bj][m][0] * r, v1 = acc[ai][bj][m][1] * r;
#pragma unroll
                    for (int e = 0; e < 4; ++e) { const float a = fmaxf(v0[e], 0.f), b = fmaxf(v1[e], 0.f); v0[e] = a * a; v1[e] = b * b; }
                    u32x4 w; w.x = cvt_pk_bf16(v0[0], v0[1]); w.y = cvt_pk_bf16(v0[2], v0[3]); w.z = cvt_pk_bf16(v1[0], v1[1]); w.w = cvt_pk_bf16(v1[2], v1[3]);
                    *(u32x4*)(rowp + bj * HALF) = w; } }
    }
};
struct EpiRes {
    static constexpr bool PERM = false, AFTER_DRAIN = false;
    const float* base; float* out; bf16_t* outb; float* ssq; const float* colscale; int ldc;
    __device__ __forceinline__ void operator()(const f32x4 (&acc)[2][2][4][2], const Unit& u, int wr, int wc, int fr, int fq) const {
        const int col0 = u.pn * BM + wc * 32 + 4 * fq;
        f32x4 cs[2][2];
#pragma unroll
        for (int bj = 0; bj < 2; ++bj)
#pragma unroll
            for (int n = 0; n < 2; ++n) cs[bj][n] = colscale ? *(const f32x4*)(colscale + col0 + bj * HALF + n * 16) : (f32x4){1.f, 1.f, 1.f, 1.f};
#pragma unroll
        for (int ai = 0; ai < 2; ++ai)
#pragma unroll
            for (int m = 0; m < 4; ++m) { const int row = u.pm * BM + ai * HALF + wr * 64 + m * 16 + fr; const size_t off = (size_t)row * ldc + col0; float s = 0.f;
#pragma unroll
                for (int bj = 0; bj < 2; ++bj)
#pragma unroll
                    for (int n = 0; n < 2; ++n) { const f32x4 b = *(const f32x4*)(base + off + bj * HALF + n * 16); const f32x4 o = b + acc[ai][bj][m][n] * cs[bj][n];
                        *(f32x4*)(out + off + bj * HALF + n * 16) = o;
                        if (outb) { u32x2 w; w.x = cvt_pk_bf16(o[0], o[1]); w.y = cvt_pk_bf16(o[2], o[3]); *(u32x2*)(outb + off + bj * HALF + n * 16) = w; }
                        s += (o[0] * o[0] + o[1] * o[1]) + (o[2] * o[2] + o[3] * o[3]); }
                if (ssq) { s += __shfl_xor(s, 16); s += __shfl_xor(s, 32); if (fq == 0) atomicAdd(ssq + row, s); } }
    }
};

__device__ __forceinline__ void ld8(const float* p, f32x4& a, f32x4& b) { a = *(const f32x4*)p; b = *(const f32x4*)(p + 4); }
__device__ __forceinline__ void ld8(const bf16_t* p, f32x4& a, f32x4& b) { const u32x4 w = *(const u32x4*)p; a = (f32x4){bflo(w.x), bfhi(w.x), bflo(w.y), bfhi(w.y)}; b = (f32x4){bflo(w.z), bfhi(w.z), bflo(w.w), bfhi(w.w)}; }
template <class BT>
struct EpiResB {
    static constexpr bool PERM = true, AFTER_DRAIN = false;
    const BT* base; bf16_t* outb; float* outf; float* ssq; const float* colscale; int ldc;
    __device__ __forceinline__ void operator()(const f32x4 (&acc)[2][2][4][2], const Unit& u, int wr, int wc, int fr, int fq) const {
        const int row0 = u.pm * BM + wr * 64 + fr, col0 = u.pn * BM + wc * 32 + 8 * fq;
        f32x4 cs[2][2];
#pragma unroll
        for (int bj = 0; bj < 2; ++bj)
#pragma unroll
            for (int n = 0; n < 2; ++n) cs[bj][n] = colscale ? *(const f32x4*)(colscale + col0 + bj * HALF + 4 * n) : (f32x4){1.f, 1.f, 1.f, 1.f};
        u32x4 raw[2][4][2];
        if constexpr (sizeof(BT) == 2) {
#pragma unroll
            for (int ai = 0; ai < 2; ++ai)
#pragma unroll
                for (int m = 0; m < 4; ++m)
#pragma unroll
                    for (int bj = 0; bj < 2; ++bj) raw[ai][m][bj] = *(const u32x4*)((const bf16_t*)base + (size_t)(row0 + ai * HALF + m * 16) * ldc + col0 + bj * HALF);
        }
#pragma unroll
        for (int ai = 0; ai < 2; ++ai)
#pragma unroll
            for (int m = 0; m < 4; ++m) { const int row = row0 + ai * HALF + m * 16; const size_t off = (size_t)row * ldc + col0; float s = 0.f;
#pragma unroll
                for (int bj = 0; bj < 2; ++bj) { f32x4 b0, b1;
                    if constexpr (sizeof(BT) == 2) { const u32x4 w_ = raw[ai][m][bj]; b0 = (f32x4){bflo(w_.x), bfhi(w_.x), bflo(w_.y), bfhi(w_.y)}; b1 = (f32x4){bflo(w_.z), bfhi(w_.z), bflo(w_.w), bfhi(w_.w)}; }
                    else ld8(base + off + bj * HALF, b0, b1);
                    const f32x4 o0 = b0 + acc[ai][bj][m][0] * cs[bj][0], o1 = b1 + acc[ai][bj][m][1] * cs[bj][1];
                    s += ((o0[0] * o0[0] + o0[1] * o0[1]) + (o0[2] * o0[2] + o0[3] * o0[3])) + ((o1[0] * o1[0] + o1[1] * o1[1]) + (o1[2] * o1[2] + o1[3] * o1[3]));
                    if (outb) { u32x4 w; w.x = cvt_pk_bf16(o0[0], o0[1]); w.y = cvt_pk_bf16(o0[2], o0[3]); w.z = cvt_pk_bf16(o1[0], o1[1]); w.w = cvt_pk_bf16(o1[2], o1[3]); *(u32x4*)(outb + off + bj * HALF) = w; }
                    if (outf) { *(f32x4*)(outf + off + bj * HALF) = o0; *(f32x4*)(outf + off + bj * HALF + 4) = o1; } }
                if (ssq) { s += __shfl_xor(s, 16); s += __shfl_xor(s, 32); if (fq == 0) atomicAdd(ssq + row, s); } }
    }
};
struct EpiFinal {
    static constexpr bool PERM = true, AFTER_DRAIN = true;
    const bf16_t* base; float* out; float* ssq; unsigned* cnt; const float* gcol; int ldc;
    __device__ __forceinline__ void operator()(f32x4 (&acc)[2][2][4][2], const Unit& u, int wr, int wc, int fr, int fq) const {
        const int row0 = u.pm * BM + wr * 64 + fr, col0 = u.pn * BM + wc * 32 + 8 * fq;
        u32x4 rawf[2][4][2];
#pragma unroll
        for (int ai = 0; ai < 2; ++ai)
#pragma unroll
            for (int m = 0; m < 4; ++m)
#pragma unroll
                for (int bj = 0; bj < 2; ++bj) rawf[ai][m][bj] = *(const u32x4*)(base + (size_t)(row0 + ai * HALF + m * 16) * ldc + col0 + bj * HALF);
#pragma unroll
        for (int ai = 0; ai < 2; ++ai)
#pragma unroll
            for (int m = 0; m < 4; ++m) { const int row = row0 + ai * HALF + m * 16; float s = 0.f;
#pragma unroll
                for (int bj = 0; bj < 2; ++bj) { const u32x4 w_ = rawf[ai][m][bj]; const f32x4 b0 = (f32x4){bflo(w_.x), bfhi(w_.x), bflo(w_.y), bfhi(w_.y)}, b1 = (f32x4){bflo(w_.z), bfhi(w_.z), bflo(w_.w), bfhi(w_.w)};
                    const f32x4 o0 = b0 + acc[ai][bj][m][0], o1 = b1 + acc[ai][bj][m][1]; acc[ai][bj][m][0] = o0; acc[ai][bj][m][1] = o1;
                    s += ((o0[0] * o0[0] + o0[1] * o0[1]) + (o0[2] * o0[2] + o0[3] * o0[3])) + ((o1[0] * o1[0] + o1[1] * o1[1]) + (o1[2] * o1[2] + o1[3] * o1[3])); }
                s += __shfl_xor(s, 16); s += __shfl_xor(s, 32); if (fq == 0) atomicAdd(ssq + row, s); }
        asm volatile("s_waitcnt vmcnt(0)" ::: "memory"); __syncthreads();
        if (threadIdx.x == 0) {
            unsigned* c = cnt + 64 * u.pm;
            __hip_atomic_fetch_add(c, 1u, __ATOMIC_RELEASE, __HIP_MEMORY_SCOPE_AGENT);
            unsigned sp = 0u;
            while (__hip_atomic_load(c, __ATOMIC_RELAXED, __HIP_MEMORY_SCOPE_AGENT) < 8u) { __builtin_amdgcn_s_sleep(2); if (++sp > (1u << 22)) break; }
            __builtin_amdgcn_fence(__ATOMIC_ACQUIRE, "agent");
        }
        __syncthreads();
        f32x4 gg[2][2];
#pragma unroll
        for (int bj = 0; bj < 2; ++bj)
#pragma unroll
            for (int n = 0; n < 2; ++n) gg[bj][n] = *(const f32x4*)(gcol + col0 + bj * HALF + 4 * n);
#pragma unroll
        for (int ai = 0; ai < 2; ++ai)
#pragma unroll
            for (int m = 0; m < 4; ++m) { const int row = row0 + ai * HALF + m * 16; const size_t off = (size_t)row * ldc + col0;
                const float r = __builtin_amdgcn_rsqf(__hip_atomic_load(ssq + row, __ATOMIC_RELAXED, __HIP_MEMORY_SCOPE_AGENT) * (1.0f / 2048.0f) + EPS);
#pragma unroll
                for (int bj = 0; bj < 2; ++bj) { *(f32x4*)(out + off + bj * HALF) = acc[ai][bj][m][0] * r * gg[bj][0]; *(f32x4*)(out + off + bj * HALF + 4) = acc[ai][bj][m][1] * r * gg[bj][1]; } }
    }
};

struct EpiPool {
    static constexpr bool PERM = true, AFTER_DRAIN = true;
    bf16_t* xb; const float* ssq_in; float* ssq_out; const float* colscale; unsigned long long* zh; unsigned* flag; int ldc; LAS unsigned char* lds;
    template <int W>
    __device__ __forceinline__ void slide(LAS bf16_t* zt, int tid, int rowT) const {
        const int col = tid & 127, q = tid >> 7; LAS bf16_t* zc = zt + col;
        const int r0 = 64 * q;
        float ring[W]; float s = 0.f;
#pragma unroll
        for (int n = 1; n < W; ++n) { ring[n] = bf2f(zc[(16 + r0 - W + n) * 136]); s += ring[n]; }
        ring[0] = 0.f;
        __syncthreads();
        for (int t0 = 0; t0 < 64; t0 += 16) {
            float zv[16];
#pragma unroll
            for (int j = 0; j < 16; ++j) zv[j] = bf2f(zc[(16 + r0 + t0 + j) * 136]);
#pragma unroll
            for (int j = 0; j < 16; ++j) { const int rr = r0 + t0 + j; const float z = zv[j]; ring[j % W] = z; s += z;
                const int gt = rowT + rr; const float cnt = (float)((gt + 1 < W) ? gt + 1 : W);
                const float y = s / cnt - z;
                zc[(16 + rr) * 136] = (bf16_t)(cvt_pk_bf16(y, 0.f) & 0xffffu);
                s -= ring[(j + 1) % W]; }
        }
    }
    __device__ __forceinline__ void operator()(const f32x4 (&acc)[2][2][4][2], const Unit& u, int wr, int wc, int fr, int fq) const {
        const int tid = threadIdx.x, w = 2 << (u.pn >> 1), rowT = u.pm * BM, unit = u.pm * 8 + u.pn;
        LAS bf16_t* zt = (LAS bf16_t*)lds;
        LAS float* rl = (LAS float*)(lds + 272 * 272);
        if (tid < 272) { const int gr = rowT - 16 + tid; rl[tid] = gr >= 0 ? __builtin_amdgcn_rsqf(ssq_in[gr] * (1.0f / 2048.0f) + EPS) : 0.f; }
        __syncthreads();
        const int hr = tid >> 5, g4 = tid & 31;
#pragma unroll
        for (int bj = 0; bj < 2; ++bj) {
#pragma unroll
            for (int ai = 0; ai < 2; ++ai)
#pragma unroll
                for (int m = 0; m < 4; ++m) { const int trow = ai * HALF + wr * 64 + m * 16 + fr; const float r = rl[16 + trow];
                    const f32x4 v0 = acc[ai][bj][m][0] * r, v1 = acc[ai][bj][m][1] * r;
                    u32x4 pk; pk.x = cvt_pk_bf16(v0[0], v0[1]); pk.y = cvt_pk_bf16(v0[2], v0[3]); pk.z = cvt_pk_bf16(v1[0], v1[1]); pk.w = cvt_pk_bf16(v1[2], v1[3]);
                    *(LAS u32x4*)(zt + (16 + trow) * 136 + wc * 32 + fq * 8) = pk; }
            __syncthreads();
            { const u32x2 v = *(const LAS u32x2*)(zt + (16 + 240 + hr) * 136 + g4 * 4);
              __hip_atomic_store(zh + ((size_t)unit * 16 + hr) * 64 + bj * 32 + g4, (unsigned long long)v.x | ((unsigned long long)v.y << 32), __ATOMIC_RELAXED, __HIP_MEMORY_SCOPE_AGENT); }
            asm volatile("s_waitcnt vmcnt(0)" ::: "memory"); __syncthreads();
            if (tid == 0) {
                __hip_atomic_fetch_add(flag + unit * 16, 1u, __ATOMIC_RELEASE, __HIP_MEMORY_SCOPE_AGENT);
                if (u.pm > 0) { unsigned sp = 0u; while (__hip_atomic_load(flag + (unit - 8) * 16, __ATOMIC_RELAXED, __HIP_MEMORY_SCOPE_AGENT) < (unsigned)(bj + 1)) { __builtin_amdgcn_s_sleep(2); if (++sp > (1u << 22)) break; }
                    __builtin_amdgcn_fence(__ATOMIC_ACQUIRE, "agent"); }
            }
            __syncthreads();
            { unsigned long long hv = 0ull;
              if (u.pm > 0) hv = __hip_atomic_load(zh + ((size_t)(unit - 8) * 16 + hr) * 64 + bj * 32 + g4, __ATOMIC_RELAXED, __HIP_MEMORY_SCOPE_AGENT);
              *(LAS u32x2*)(zt + hr * 136 + g4 * 4) = (u32x2){(unsigned)hv, (unsigned)(hv >> 32)}; }
            __syncthreads();
            if (w == 2) slide<2>(zt, tid, rowT); else if (w == 4) slide<4>(zt, tid, rowT); else if (w == 8) slide<8>(zt, tid, rowT); else slide<16>(zt, tid, rowT);
            __syncthreads();
            const int row0 = rowT + wr * 64 + fr, col0 = u.pn * BM + bj * HALF + wc * 32 + 8 * fq;
            const f32x4 cs0 = *(const f32x4*)(colscale + col0), cs1 = *(const f32x4*)(colscale + col0 + 4);
            u32x4 rawp[2][4];
#pragma unroll
            for (int ai = 0; ai < 2; ++ai)
#pragma unroll
                for (int m = 0; m < 4; ++m) rawp[ai][m] = *(const u32x4*)(xb + (size_t)(rowT + ai * HALF + wr * 64 + m * 16 + fr) * ldc + col0);
#pragma unroll
            for (int ai = 0; ai < 2; ++ai)
#pragma unroll
                for (int m = 0; m < 4; ++m) { const int trow = ai * HALF + wr * 64 + m * 16 + fr, row = rowT + trow; const size_t off = (size_t)row * ldc + col0;
                    const u32x4 yw = *(const LAS u32x4*)(zt + (16 + trow) * 136 + wc * 32 + fq * 8);
                    const f32x4 y0 = (f32x4){bflo(yw.x), bfhi(yw.x), bflo(yw.y), bfhi(yw.y)}, y1 = (f32x4){bflo(yw.z), bfhi(yw.z), bflo(yw.w), bfhi(yw.w)};
                    const u32x4 w_ = rawp[ai][m]; const f32x4 b0 = (f32x4){bflo(w_.x), bfhi(w_.x), bflo(w_.y), bfhi(w_.y)}, b1 = (f32x4){bflo(w_.z), bfhi(w_.z), bflo(w_.w), bfhi(w_.w)};
                    const f32x4 o0 = b0 + y0 * cs0, o1 = b1 + y1 * cs1;
                    float sq = ((o0[0] * o0[0] + o0[1] * o0[1]) + (o0[2] * o0[2] + o0[3] * o0[3])) + ((o1[0] * o1[0] + o1[1] * o1[1]) + (o1[2] * o1[2] + o1[3] * o1[3]));
                    u32x4 ow; ow.x = cvt_pk_bf16(o0[0], o0[1]); ow.y = cvt_pk_bf16(o0[2], o0[3]); ow.z = cvt_pk_bf16(o1[0], o1[1]); ow.w = cvt_pk_bf16(o1[2], o1[3]); *(u32x4*)(xb + off) = ow;
                    sq += __shfl_xor(sq, 16); sq += __shfl_xor(sq, 32); if (fq == 0) atomicAdd(ssq_out + row, sq); }
            (void)row0;
            __syncthreads();
        }
    }
};

template <class Epi, class Sched, bool ALIGN_EPI>
__device__ __forceinline__ void gemm_phase(LAS unsigned char* lds, const Gemm g, const Sched& S, const Epi& E) {
    const int tid = threadIdx.x, wid = __builtin_amdgcn_readfirstlane(tid >> 6), lane = tid & 63, wr = wid >> 2, wc = wid & 3, fr = lane & 15, fq = lane >> 4;
    const int K = g.K, nt = K / BK;
    unsigned voffA[2], voffB[2];
#pragma unroll
    for (int i = 0; i < 2; ++i) { int R, C; stage_rc(tid * 16 + i * 8192, R, C); const int Rb = Epi::PERM ? ((R & ~31) + perm32(R & 31)) : R;
        voffA[i] = (unsigned)(R * g.lda + C) * 2u; voffB[i] = (unsigned)(Rb * g.ldb + C) * 2u; }
    const size_t kstep = (size_t)(BK * 2);
    const size_t hstepA = (size_t)HALF * g.lda * 2, hstepB = (size_t)HALF * g.ldb * 2;
    const size_t tstepA = 2 * hstepA, tstepB = 2 * hstepB;
    const unsigned ldsw = (unsigned)wid * 1024u;
    const int aoff = lds_byte(wr * 64 + fr, fq * 8), boff = lds_byte(wc * 32 + fr, fq * 8);
#define PG8_UA(u) ((const char*)g.A + (size_t)(u).pm * tstepA + (size_t)((u).pn >> g.a_pn_shift) * (size_t)g.a_pn_bytes)
#define PG8_UB(u) ((const char*)g.Bt + (size_t)(u).pn * tstepB)
#define PG8_SA(b, h) (((b) * 2 + (h)) * HTB)
#define PG8_SB(b, h) ((4 + (b) * 2 + (h)) * HTB)
#define PG8_STAGE(bufoff, gbase, voff) do { _Pragma("unroll") for (int _i = 0; _i < 2; ++_i) \
        __builtin_amdgcn_global_load_lds((const unsigned*)((const char*)(gbase) + (voff)[_i]), (LAS unsigned*)(lds + (bufoff) + ldsw + _i * 8192), 16, 0, 0); } while (0)
#define PG8_LDA(dst, b, h) do { _Pragma("unroll") for (int m = 0; m < 4; ++m) _Pragma("unroll") for (int k = 0; k < 2; ++k) dst[m][k] = *(const LAS bf16x8*)(lds + PG8_SA(b, h) + aoff + m * 2048 + k * 1024); } while (0)
#define PG8_LDB(dst, b, h) do { _Pragma("unroll") for (int n = 0; n < 2; ++n) _Pragma("unroll") for (int k = 0; k < 2; ++k) dst[n][k] = *(const LAS bf16x8*)(lds + PG8_SB(b, h) + boff + n * 2048 + k * 1024); } while (0)
#define PG8_MMA(ai, bj, At, Bt) do { __builtin_amdgcn_s_setprio(1); _Pragma("unroll") for (int m = 0; m < 4; ++m) _Pragma("unroll") for (int n = 0; n < 2; ++n) _Pragma("unroll") for (int k = 0; k < 2; ++k) \
        acc[ai][bj][m][n] = __builtin_amdgcn_mfma_f32_16x16x32_bf16(Bt[n][k], At[m][k], acc[ai][bj][m][n], 0, 0, 0); __builtin_amdgcn_s_setprio(0); } while (0)
#define PG8_WAIT_V(n) asm volatile("s_waitcnt vmcnt(" #n ")" ::: "memory")
#define PG8_WAIT_L(n) asm volatile("s_waitcnt lgkmcnt(" #n ")" ::: "memory")
#define PG8_BAR __builtin_amdgcn_s_barrier()
#define PG8_SCHED __builtin_amdgcn_sched_barrier(0)
    Unit cur, nxt; int ui = 0;
    if (!S.next(0, cur)) return;
    f32x4 acc[2][2][4][2];
#pragma unroll
    for (int a = 0; a < 2; ++a)
#pragma unroll
        for (int b = 0; b < 2; ++b)
#pragma unroll
            for (int m = 0; m < 4; ++m)
#pragma unroll
                for (int n = 0; n < 2; ++n) acc[a][b][m][n] = (f32x4){0.f, 0.f, 0.f, 0.f};
    bf16x8 At[4][2], B0[2][2], B1[2][2];
    const char* cA = PG8_UA(cur); const char* cB = PG8_UB(cur);
    PG8_STAGE(PG8_SB(0, 0), cB, voffB); PG8_STAGE(PG8_SB(0, 1), cB + hstepB, voffB); PG8_STAGE(PG8_SA(0, 0), cA, voffA); PG8_STAGE(PG8_SA(0, 1), cA + hstepA, voffA);
    if (wr == 1) PG8_BAR;
    PG8_WAIT_V(2); PG8_BAR;
    PG8_STAGE(PG8_SB(1, 0), cB + kstep, voffB); PG8_STAGE(PG8_SA(1, 0), cA + kstep, voffA); PG8_STAGE(PG8_SB(1, 1), cB + hstepB + kstep, voffB);
    PG8_WAIT_V(6); PG8_BAR;
    for (;;) {
        const bool has_next = S.next(ui + 1, nxt);
        const char* nA = has_next ? PG8_UA(nxt) : cA; const char* nB = has_next ? PG8_UB(nxt) : cB;
        for (int t = 0; t < nt; t += 2) {
            const bool last = (t == nt - 2);
            const char* a1 = cA + (size_t)(t + 1) * kstep;
            const char* a2 = last ? nA : cA + (size_t)(t + 2) * kstep; const char* b2 = last ? nB : cB + (size_t)(t + 2) * kstep;
            const char* a3 = a2 + kstep; const char* b3 = b2 + kstep;
            PG8_LDB(B0, 0, 0); PG8_LDB(B1, 0, 1); PG8_SCHED; PG8_LDA(At, 0, 0); PG8_STAGE(PG8_SA(1, 1), a1 + hstepA, voffA);
            PG8_WAIT_V(8); PG8_WAIT_L(0); PG8_BAR; PG8_MMA(0, 0, At, B0); PG8_MMA(0, 1, At, B1); PG8_BAR; PG8_SCHED;
            PG8_LDA(At, 0, 1); PG8_STAGE(PG8_SB(0, 0), b2, voffB); PG8_STAGE(PG8_SB(0, 1), b2 + hstepB, voffB); PG8_STAGE(PG8_SA(0, 0), a2, voffA);
            PG8_WAIT_V(8); PG8_WAIT_L(0); PG8_BAR; PG8_MMA(1, 0, At, B0); PG8_MMA(1, 1, At, B1); PG8_BAR; PG8_SCHED;
            PG8_LDB(B0, 1, 0); PG8_LDB(B1, 1, 1); PG8_SCHED; PG8_LDA(At, 1, 0); PG8_STAGE(PG8_SA(0, 1), a2 + hstepA, voffA);
            PG8_WAIT_V(8); PG8_WAIT_L(0); PG8_BAR; PG8_MMA(0, 0, At, B0); PG8_MMA(0, 1, At, B1); PG8_BAR; PG8_SCHED;
            PG8_LDA(At, 1, 1); PG8_STAGE(PG8_SB(1, 0), b3, voffB); PG8_STAGE(PG8_SB(1, 1), b3 + hstepB, voffB); PG8_STAGE(PG8_SA(1, 0), a3, voffA);
            PG8_WAIT_V(8); PG8_WAIT_L(0); PG8_BAR; PG8_MMA(1, 0, At, B0); PG8_MMA(1, 1, At, B1); PG8_BAR; PG8_SCHED;
        }
        if constexpr (ALIGN_EPI) { if (wr == 0) PG8_BAR; }
        if constexpr (!Epi::AFTER_DRAIN) E(acc, cur, wr, wc, fr, fq);
        if (!has_next) break;
#pragma unroll
        for (int a = 0; a < 2; ++a)
#pragma unroll
            for (int b = 0; b < 2; ++b)
#pragma unroll
                for (int m = 0; m < 4; ++m)
#pragma unroll
                    for (int n = 0; n < 2; ++n) acc[a][b][m][n] = (f32x4){0.f, 0.f, 0.f, 0.f};
        cur = nxt; cA = nA; cB = nB; ++ui;
        if constexpr (ALIGN_EPI) { if (wr == 1) PG8_BAR; }
    }
    PG8_WAIT_V(0);
    if constexpr (!ALIGN_EPI) { if (wr == 0) PG8_BAR; }
    PG8_BAR;
    if constexpr (Epi::AFTER_DRAIN) E(acc, cur, wr, wc, fr, fq);
#undef PG8_UA
#undef PG8_UB
#undef PG8_SA
#undef PG8_SB
#undef PG8_STAGE
#undef PG8_LDA
#undef PG8_LDB
#undef PG8_MMA
#undef PG8_WAIT_V
#undef PG8_WAIT_L
#undef PG8_BAR
#undef PG8_SCHED
}
}

__device__ __forceinline__ float wave_sum(float v) {
#pragma unroll
    for (int o = 1; o < 64; o <<= 1) v += __shfl_xor(v, o);
    return v;
}
__device__ __forceinline__ void transpose_item(const float* W, int K, int N, int Npad, int Nst, bf16_t* WT, const float* gk, LAS float* scr, int item, int lane, bool glu_map = false) {
    const int nblk = Npad / 128, kb = item / nblk, nb = item % nblk, k0 = 32 * kb, n0 = 128 * nb;
    const int nn = n0 + 4 * (lane & 31), kh = lane >> 5; const bool ok = nn < N;
    f32x4 v[16];
#pragma unroll
    for (int i = 0; i < 16; ++i) v[i] = ok ? __builtin_nontemporal_load((const f32x4*)(W + (size_t)(k0 + 2 * i + kh) * N + nn)) : (f32x4){0.f, 0.f, 0.f, 0.f};
    if (gk) {
#pragma unroll
        for (int i = 0; i < 16; ++i) v[i] *= gk[k0 + 2 * i + kh];
    }
#pragma unroll
    for (int i = 0; i < 16; ++i) *(LAS f32x4*)(scr + (2 * i + kh) * 132 + 4 * (lane & 31)) = v[i];
    asm volatile("s_waitcnt lgkmcnt(0)" ::: "memory");
    const int kq = lane & 3;
#pragma unroll
    for (int j = 0; j < 8; ++j) { const int n = (lane >> 2) + 16 * j; const LAS float* sp = scr + (8 * kq) * 132 + n;
        u32x4 o; o.x = cvt_pk_bf16(sp[0 * 132], sp[1 * 132]); o.y = cvt_pk_bf16(sp[2 * 132], sp[3 * 132]); o.z = cvt_pk_bf16(sp[4 * 132], sp[5 * 132]); o.w = cvt_pk_bf16(sp[6 * 132], sp[7 * 132]);
        const int nbo = glu_map ? (nb < 8 ? 2 * nb : (nb < 16 ? 2 * (nb - 8) + 1 : nb)) : nb;
        if (n0 + n < Nst) *(u32x4*)(WT + (size_t)(128 * nbo + n) * K + k0 + 8 * kq) = o; }
    asm volatile("s_waitcnt lgkmcnt(0)" ::: "memory");
}

struct TDesc { const float* W; bf16_t* WT; const float* gk; int K, N, Npad, Nst, item, glu; };
__device__ __forceinline__ void t_load(const TDesc& d, int lane, f32x4 (&v)[16]) {
    const int nblk = d.Npad / 128, kb = d.item / nblk, nb = d.item % nblk, k0 = 32 * kb, n0 = 128 * nb;
    const int nn = n0 + 4 * (lane & 31), kh = lane >> 5; const bool ok = nn < d.N;
#pragma unroll
    for (int i = 0; i < 16; ++i) v[i] = ok ? __builtin_nontemporal_load((const f32x4*)(d.W + (size_t)(k0 + 2 * i + kh) * d.N + nn)) : (f32x4){0.f, 0.f, 0.f, 0.f};
}
__device__ __forceinline__ void t_finish(const TDesc& d, int lane, LAS float* scr, f32x4 (&v)[16]) {
    const int nblk = d.Npad / 128, kb = d.item / nblk, nb = d.item % nblk, k0 = 32 * kb, n0 = 128 * nb, kh = lane >> 5;
    if (d.gk) {
#pragma unroll
        for (int i = 0; i < 16; ++i) v[i] *= d.gk[k0 + 2 * i + kh];
    }
#pragma unroll
    for (int i = 0; i < 16; ++i) *(LAS f32x4*)(scr + (2 * i + kh) * 132 + 4 * (lane & 31)) = v[i];
    asm volatile("s_waitcnt lgkmcnt(0)" ::: "memory");
    const int kq = lane & 3;
#pragma unroll
    for (int j = 0; j < 8; ++j) { const int n = (lane >> 2) + 16 * j; const LAS float* sp = scr + (8 * kq) * 132 + n;
        u32x4 o; o.x = cvt_pk_bf16(sp[0 * 132], sp[1 * 132]); o.y = cvt_pk_bf16(sp[2 * 132], sp[3 * 132]); o.z = cvt_pk_bf16(sp[4 * 132], sp[5 * 132]); o.w = cvt_pk_bf16(sp[6 * 132], sp[7 * 132]);
        const int nbo = d.glu ? (nb < 8 ? 2 * nb : (nb < 16 ? 2 * (nb - 8) + 1 : nb)) : nb;
        if (n0 + n < d.Nst) *(u32x4*)(d.WT + (size_t)(128 * nbo + n) * d.K + k0 + 8 * kq) = o; }
    asm volatile("s_waitcnt lgkmcnt(0)" ::: "memory");
}

struct Args { const float* in[20]; float* out; unsigned char* ws; int ph_lo, ph_hi; };

__device__ __forceinline__ void conv_tile(LAS unsigned char* lds, const bf16_t* PROJ, const float* conv_w, const float* conv_b, const float* ln_g, const float* ln_b, bf16_t* CO, int tile) {
    const int tid = threadIdx.x, lane = tid & 63, wid = tid >> 6, c0 = 2 * tid, t0 = tile * 16;
    f32x2 w[31];
#pragma unroll
    for (int k = 0; k < 31; ++k) w[k] = *(const f32x2*)(conv_w + k * 1024 + c0);
    const f32x2 bias = *(const f32x2*)(conv_b + c0);
    f32x2 u[46];
    const bf16_t* pp = PROJ + ((long)t0 - 30) * LDP + 256 * (c0 >> 7) + (c0 & 127);
#pragma unroll
    for (int sidx = 0; sidx < 46; ++sidx) { unsigned ru = 0u; if (t0 - 30 + sidx >= 0) ru = *(const unsigned*)(pp + (size_t)sidx * LDP); u[sidx] = (f32x2){bflo(ru), bfhi(ru)}; }
    f32x2 acc[16];
#pragma unroll
    for (int o = 0; o < 16; ++o) { f32x2 a = bias;
#pragma unroll
        for (int k = 0; k < 31; ++k) a += u[o + 30 - k] * w[30 - k];
        acc[o] = a; }
    LAS f32x2* part = (LAS f32x2*)lds;
    LAS float* red = (LAS float*)(lds + 65536);
#pragma unroll
    for (int o = 0; o < 16; ++o) part[o * 512 + tid] = (f32x2){acc[o].x + acc[o].y, acc[o].x * acc[o].x + acc[o].y * acc[o].y};
    __syncthreads();
    { const int o = tid >> 5, sg = tid & 31; f32x2 a = (f32x2){0.f, 0.f};
#pragma unroll
        for (int e = 0; e < 16; ++e) a += part[o * 512 + e * 32 + sg];
#pragma unroll
        for (int sh = 1; sh < 32; sh <<= 1) { a.x += __shfl_xor(a.x, sh); a.y += __shfl_xor(a.y, sh); }
        if (sg == 0) { red[o * 2] = a.x; red[o * 2 + 1] = a.y; } }
    __syncthreads();
    const f32x2 gg = *(const f32x2*)(ln_g + c0), bb = *(const f32x2*)(ln_b + c0);
#pragma unroll
    for (int o = 0; o < 16; ++o) { const float s1 = red[o * 2], s2 = red[o * 2 + 1];
        const float mean = s1 * (1.f / 1024.f), var = fmaxf(s2 * (1.f / 1024.f) - mean * mean, 0.f), rstd = __builtin_amdgcn_rsqf(var + EPS);
        float y0 = (acc[o].x - mean) * rstd * gg.x + bb.x, y1 = (acc[o].y - mean) * rstd * gg.y + bb.y;
        y0 = y0 * sigmoidf_(y0); y1 = y1 * sigmoidf_(y1);
        *(unsigned*)(CO + (size_t)(t0 + o) * DM + c0) = cvt_pk_bf16(y0, y1); }
    __syncthreads();
}

__device__ __forceinline__ void compress_unit(LAS unsigned char* lds, const bf16_t* PROJ, const float* pos, const bf16_t* w1t, const bf16_t* w2t, bf16_t* outp, int kv, int g, int ntile) {
    const int tid = threadIdx.x, lane = tid & 63, wid = __builtin_amdgcn_readfirstlane(tid >> 6), fr = lane & 15, fq = lane >> 4;
    const int n = ntile * 16 + fr; const bool ok = n < 511;
    const int coloff = (kv ? OFF_VC : OFF_KC) + g * 64;
    const bf16_t* arow = PROJ + (size_t)(16 * (ok ? n : 0)) * LDP + coloff + fq * 8;
    u32x4 av[8];
#pragma unroll
    for (int e = 0; e < 8; ++e) { const int kk = wid * 8 + e, l = kk >> 1, d = (kk & 1) * 32; av[e] = *(const u32x4*)(arow + (size_t)l * LDP + d); }
    bf16x8 ab[8];
#pragma unroll
    for (int e = 0; e < 8; ++e) { const int kk = wid * 8 + e, l = kk >> 1, d = (kk & 1) * 32; const u32x4 a = av[e];
        const f32x4 p0 = *(const f32x4*)(pos + l * 64 + d + fq * 8), p1 = *(const f32x4*)(pos + l * 64 + d + fq * 8 + 4);
        u32x4 t;
        t.x = cvt_pk_bf16(bflo(a.x) + p0[0], bfhi(a.x) + p0[1]); t.y = cvt_pk_bf16(bflo(a.y) + p0[2], bfhi(a.y) + p0[3]);
        t.z = cvt_pk_bf16(bflo(a.z) + p1[0], bfhi(a.z) + p1[1]); t.w = cvt_pk_bf16(bflo(a.w) + p1[2], bfhi(a.w) + p1[3]);
        if (!ok) t = (u32x4){0u, 0u, 0u, 0u};
        ab[e] = __builtin_bit_cast(bf16x8, t); }
    LAS float* psum = (LAS float*)lds;
    LAS bf16_t* hb = (LAS bf16_t*)(lds + 65536);
#pragma unroll
    for (int ct = 0; ct < 8; ++ct) {
        const bf16_t* brow = w1t + (size_t)(ct * 16 + fr) * 2048 + wid * 256 + fq * 8;
        bf16x8 bv[8];
#pragma unroll
        for (int e = 0; e < 8; ++e) bv[e] = *(const bf16x8*)(brow + e * 32);
        f32x4 acc = (f32x4){0.f, 0.f, 0.f, 0.f};
#pragma unroll
        for (int e = 0; e < 8; ++e) acc = __builtin_amdgcn_mfma_f32_16x16x32_bf16(ab[e], bv[e], acc, 0, 0, 0);
#pragma unroll
        for (int j = 0; j < 4; ++j) psum[wid * 2048 + (fq * 4 + j) * 128 + ct * 16 + fr] = acc[j];
    }
    __syncthreads();
    { f32x4 t = *(const LAS f32x4*)(psum + tid * 4);
#pragma unroll
        for (int v = 1; v < 8; ++v) t += *(const LAS f32x4*)(psum + v * 2048 + tid * 4);
        const int nr = tid >> 5, hc = (tid & 31) * 4;
        u32x2 o; o.x = cvt_pk_bf16(t[0] * sigmoidf_(t[0]), t[1] * sigmoidf_(t[1])); o.y = cvt_pk_bf16(t[2] * sigmoidf_(t[2]), t[3] * sigmoidf_(t[3]));
        *(LAS u32x2*)(hb + nr * 136 + hc) = o; }
    __syncthreads();
    if (wid < 4) {
        f32x4 o = (f32x4){0.f, 0.f, 0.f, 0.f};
#pragma unroll
        for (int kk = 0; kk < 4; ++kk) {
            const bf16x8 af = *(const LAS bf16x8*)(hb + fr * 136 + kk * 32 + fq * 8);
            const bf16x8 bf = *(const bf16x8*)(w2t + (size_t)(wid * 16 + fr) * 128 + kk * 32 + fq * 8);
            o = __builtin_amdgcn_mfma_f32_16x16x32_bf16(af, bf, o, 0, 0, 0);
        }
        const int col = wid * 16 + fr;
#pragma unroll
        for (int j = 0; j < 4; ++j) { const int nn = ntile * 16 + fq * 4 + j; const bf16_t v = (bf16_t)(cvt_pk_bf16(o[j], 0.f) & 0xffffu);
            outp[((size_t)g * 512 + nn) * 64 + col] = v; }
    }
    __syncthreads();
}

namespace att {
constexpr int SLOT = 16384, LDS_FIN = 65536, LDS_IMP = 65536  , IMPROW = 129, LDS_SEL = 131072, LDS_END = LDS_SEL + 1024;
constexpr float C2 = 0.125f * 1.4426950408889634f;
constexpr float NEG = -1e30f;

template <int MODE, bool FULL, int POS>
__device__ __forceinline__ void tile_body(LAS unsigned char* lds, LAS unsigned char* kb, int tile, const bf16x8 (&qf)[2][2], int t0, float (&m)[2], float (&l)[2], bool (&ini)[2], f32x4 (&oacc)[2][4], bf16x8 (&kfx)[4][2]) {
    int tid = threadIdx.x; asm volatile("" : "+v"(tid));
    const int lane = tid & 63, fr = lane & 15, fq = lane >> 4;
    LAS unsigned* impu = (LAS unsigned*)(lds + LDS_IMP); LAS unsigned* sel = (LAS unsigned*)(lds + LDS_SEL);
    const int swz = (fr >> 1) & 7;
    const int key0 = tile * 64;
    const int tlb = ((tid >> 6) & 1) * 32 + fr;
    constexpr float THR = 8.0f, NINF = -INFINITY;
    float ci[2];
#pragma unroll
    for (int qs = 0; qs < 2; ++qs) {
        if (MODE == 1) ci[qs] = m[qs]; else ci[qs] = ini[qs] ? -m[qs] : 0.f;
        if (MODE == 2) { const bool selb = ((sel[(tlb + qs * 16) * 4 + (tile >> 5)] >> (tile & 31)) & 1u) != 0u; if (!selb) ci[qs] = NINF; }
    }
    f32x4 sacc[2][4];
#pragma unroll
    for (int ks = 0; ks < 4; ++ks) {
        bf16x8 k0, k1;
        if (POS == 0) { k0 = *(const LAS bf16x8*)(kb + (ks * 16 + fr) * 128 + ((fq ^ swz) * 16)); k1 = *(const LAS bf16x8*)(kb + (ks * 16 + fr) * 128 + (((4 + fq) ^ swz) * 16)); }
        else { k0 = kfx[ks][0]; k1 = kfx[ks][1]; }
#pragma unroll
        for (int qs = 0; qs < 2; ++qs) { f32x4 z = (f32x4){ci[qs], ci[qs], ci[qs], ci[qs]};
            z = __builtin_amdgcn_mfma_f32_16x16x32_bf16(k0, qf[qs][0], z, 0, 0, 0); sacc[qs][ks] = __builtin_amdgcn_mfma_f32_16x16x32_bf16(k1, qf[qs][1], z, 0, 0, 0); }
    }
    bf16x8 pf[2][2];
#pragma unroll
    for (int qs = 0; qs < 2; ++qs) {
        if constexpr (!FULL) {
            const int t = t0 + tlb + qs * 16;
#pragma unroll
            for (int ks = 0; ks < 4; ++ks)
#pragma unroll
                for (int j = 0; j < 4; ++j) { const int key = key0 + ks * 16 + fq * 4 + j; bool valid;
                    if (MODE <= 1) valid = (16 * key + 31 <= t); else if (MODE == 2) valid = (key <= t); else valid = (key <= t) && (key > t - 512);
                    if (!valid) sacc[qs][ks][j] = NINF; }
        }
        if (MODE == 1) {
            const int tl = tlb + qs * 16;
#pragma unroll
            for (int ks = 0; ks < 4; ++ks) { float p[4];
#pragma unroll
                for (int j = 0; j < 4; ++j) { p[j] = fexp2(sacc[qs][ks][j]); sacc[qs][ks][j] = p[j]; }
                const int j0 = (key0 + ks * 16 + fq * 4) >> 2;
                const float s4 = (p[0] + p[1]) + (p[2] + p[3]);
                if (FULL || s4 > 0.f) { __hip_atomic_fetch_add(&impu[tl * IMPROW + j0], (unsigned)(s4 * 134217728.0f + 0.5f), __ATOMIC_RELAXED, __HIP_MEMORY_SCOPE_WORKGROUP);
                    if (j0 + 1 < 128) __hip_atomic_fetch_add(&impu[tl * IMPROW + j0 + 1], (unsigned)(p[3] * 134217728.0f + 0.5f), __ATOMIC_RELAXED, __HIP_MEMORY_SCOPE_WORKGROUP); } }
        } else {
            float mt = fmaxf(fmaxf(sacc[qs][0][0], sacc[qs][0][1]), fmaxf(sacc[qs][0][2], sacc[qs][0][3]));
#pragma unroll
            for (int ks = 1; ks < 4; ++ks) mt = fmaxf(mt, fmaxf(fmaxf(sacc[qs][ks][0], sacc[qs][ks][1]), fmaxf(sacc[qs][ks][2], sacc[qs][ks][3])));
            const bool trig = (mt > THR) || (!ini[qs] && mt > NINF);
            if (__any(trig)) {
                float rm = mt;
                if (MODE >= 2) { rm = fmaxf(rm, __shfl_xor(rm, 16)); rm = fmaxf(rm, __shfl_xor(rm, 32)); }
                float delta = 0.f;
                if (!ini[qs]) { if (rm > NINF) { delta = rm; ini[qs] = true; m[qs] = rm; } }
                else { delta = fmaxf(rm, 0.f); m[qs] += delta; const float alpha = fexp2(-delta); l[qs] *= alpha;
                    if (MODE >= 2) {
#pragma unroll
                        for (int ds = 0; ds < 4; ++ds) oacc[qs][ds] *= alpha; } }
#pragma unroll
                for (int ks = 0; ks < 4; ++ks) sacc[qs][ks] -= delta;
            }
            float ps = 0.f;
#pragma unroll
            for (int ks = 0; ks < 4; ++ks)
#pragma unroll
                for (int j = 0; j < 4; ++j) { const float p = fexp2(sacc[qs][ks][j]); sacc[qs][ks][j] = p; ps += p; }
            l[qs] += ps;
        }
        if (MODE != 0) {
#pragma unroll
            for (int kc = 0; kc < 2; ++kc) { u32x4 w; const f32x4 a = sacc[qs][2 * kc], b = sacc[qs][2 * kc + 1];
                w.x = cvt_pk_bf16(a[0], a[1]); w.y = cvt_pk_bf16(a[2], a[3]); w.z = cvt_pk_bf16(b[0], b[1]); w.w = cvt_pk_bf16(b[2], b[3]); pf[qs][kc] = __builtin_bit_cast(bf16x8, w); }
        }
    }
    if (POS == 0) {
#pragma unroll
        for (int ks = 0; ks < 4; ++ks) { kfx[ks][0] = *(const LAS bf16x8*)(kb + SLOT + (ks * 16 + fr) * 128 + ((fq ^ swz) * 16)); kfx[ks][1] = *(const LAS bf16x8*)(kb + SLOT + (ks * 16 + fr) * 128 + (((4 + fq) ^ swz) * 16)); }
    }
    if (MODE != 0) {
#pragma unroll
        for (int ds = 0; ds < 4; ++ds)
#pragma unroll
            for (int kc = 0; kc < 2; ++kc) {
                const int vr0 = 32 * kc + 4 * fq + (fr >> 2), vr1 = vr0 + 16, vch = 2 * ds + ((fr & 3) >> 1);
                const v4i16_t t0 = __builtin_amdgcn_ds_read_tr16_b64_v4i16((LAS v4i16_t*)(kb + 8192 + vr0 * 128 + ((vch ^ ((vr0 >> 1) & 7)) * 16) + (fr & 1) * 8));
                const v4i16_t t1 = __builtin_amdgcn_ds_read_tr16_b64_v4i16((LAS v4i16_t*)(kb + 8192 + vr1 * 128 + ((vch ^ ((vr1 >> 1) & 7)) * 16) + (fr & 1) * 8));
                const bf16x8 vf = (bf16x8){t0[0], t0[1], t0[2], t0[3], t1[0], t1[1], t1[2], t1[3]};
#pragma unroll
                for (int qs = 0; qs < 2; ++qs) oacc[qs][ds] = __builtin_amdgcn_mfma_f32_16x16x32_bf16(vf, pf[qs][kc], oacc[qs][ds], 0, 0, 0);
            }
    }
}

template <int MODE>
__device__ __forceinline__ void branch(LAS unsigned char* lds, const bf16_t* kbase, int kstride, const bf16_t* vbase, int vstride, int tlo, int thi,
                                       const bf16x8 (&qf)[2][2], int itile, float (&m)[2], float (&l)[2], bool (&ini)[2], f32x4 (&oacc)[2][4],
                                       int& slot_io, bool preloaded, bool has_next, const bf16_t* nkbase, int nkstride, const bf16_t* nvbase, int nvstride, int ntlo, int nthi) {
    const int wid = __builtin_amdgcn_readfirstlane((int)threadIdx.x >> 6);
#define ATT_OFFS(ks_, vs_) int tid_ = threadIdx.x; asm volatile("" : "+v"(tid_)); const int lane_ = tid_ & 63, lr = (tid_ >> 6) * 8 + (lane_ >> 3), lc = (lane_ & 7) ^ ((lr >> 1) & 7); \
        const unsigned koff = (unsigned)(lr * (ks_) + lc * 8) * 2u, voff = (unsigned)(lr * (vs_) + lc * 8) * 2u; const unsigned nkoff = koff, nvoff = voff; (void)nkoff; (void)nvoff
#define ATT_DMA(t, slot) do { __builtin_amdgcn_global_load_lds((const unsigned*)((const char*)kbase + (size_t)(t) * 128 * kstride + koff), (LAS unsigned*)(lds + (slot) * SLOT + wid * 1024), 16, 0, 0); \
        __builtin_amdgcn_global_load_lds((const unsigned*)((const char*)vbase + (size_t)(t) * 128 * vstride + voff), (LAS unsigned*)(lds + (slot) * SLOT + 8192 + wid * 1024), 16, 0, 0); } while (0)
#define ATT_NDMA(t, slot) do { __builtin_amdgcn_global_load_lds((const unsigned*)((const char*)nkbase + (size_t)(t) * 128 * nkstride + nkoff), (LAS unsigned*)(lds + (slot) * SLOT + wid * 1024), 16, 0, 0); \
        __builtin_amdgcn_global_load_lds((const unsigned*)((const char*)nvbase + (size_t)(t) * 128 * nvstride + nvoff), (LAS unsigned*)(lds + (slot) * SLOT + 8192 + wid * 1024), 16, 0, 0); } while (0)
    int slot = slot_io;
    if (!preloaded) { __builtin_amdgcn_s_barrier();
        ATT_OFFS(kstride, vstride); slot = 0; ATT_DMA(tlo, 0); if (tlo + 1 <= thi) ATT_DMA(tlo + 1, 1); }
    for (int tile = tlo; tile <= thi; tile += 2) {
        asm volatile("s_waitcnt vmcnt(0)" ::: "memory"); __builtin_amdgcn_s_barrier(); asm volatile("" ::: "memory");
        if (tile + 2 <= thi) { ATT_OFFS(kstride, vstride); ATT_DMA(tile + 2, slot ^ 2); if (tile + 3 <= thi) ATT_DMA(tile + 3, (slot ^ 2) + 1); }
        else if (has_next) { ATT_OFFS(nkstride, nvstride); ATT_NDMA(ntlo, slot ^ 2); if (ntlo + 1 <= nthi) ATT_NDMA(ntlo + 1, (slot ^ 2) + 1); }
        bf16x8 kfx[4][2];
        { const int tt = tile; bool full;
          if (MODE <= 1) full = (1024 * tt + 1039 <= 64 * itile); else if (MODE == 2) full = tt < itile; else full = (tt < itile) && (tt > itile - 8);
          if (full) tile_body<MODE, true, 0>(lds, lds + slot * SLOT, tt, qf, itile * 64, m, l, ini, oacc, kfx);
          else tile_body<MODE, false, 0>(lds, lds + slot * SLOT, tt, qf, itile * 64, m, l, ini, oacc, kfx); }
        if (tile + 1 <= thi) { const int tt = tile + 1; bool full;
          if (MODE <= 1) full = (1024 * tt + 1039 <= 64 * itile); else if (MODE == 2) full = tt < itile; else full = (tt < itile) && (tt > itile - 8);
          if (full) tile_body<MODE, true, 1>(lds, lds + (slot + 1) * SLOT, tt, qf, itile * 64, m, l, ini, oacc, kfx);
          else tile_body<MODE, false, 1>(lds, lds + (slot + 1) * SLOT, tt, qf, itile * 64, m, l, ini, oacc, kfx); }
        slot ^= 2;
    }
    slot_io = slot;
    asm volatile("s_waitcnt lgkmcnt(0)" ::: "memory"); __builtin_amdgcn_s_barrier(); asm volatile("" ::: "memory");
#undef ATT_DMA
#undef ATT_NDMA
#undef ATT_OFFS
}

__device__ __forceinline__ void unit(LAS unsigned char* lds, const bf16_t* PROJ, const bf16_t* KC, const bf16_t* VCT, const bf16_t* VTS, const bf16_t* VTW, bf16_t* CO, int i, int g) {
    const int tid = threadIdx.x, lane = tid & 63, wid = __builtin_amdgcn_readfirstlane(tid >> 6), fr = lane & 15, fq = lane >> 4;
    const int r = wid >> 1, th = wid & 1, h = g * 4 + r, t0 = i * 64, tlb = th * 32 + fr;
    LAS unsigned* impu = (LAS unsigned*)(lds + LDS_IMP); LAS unsigned* sel = (LAS unsigned*)(lds + LDS_SEL);
    int tq[2]; bf16x8 qf[2][2];
#define ATT_GATE(qs, b) sigmoidf_(bf2f(PROJ[(size_t)tq[qs] * LDP + OFF_GL + h * 3 + (b)]))
#pragma unroll
    for (int qs = 0; qs < 2; ++qs) { tq[qs] = t0 + th * 32 + qs * 16 + fr;
#pragma unroll
        for (int dc = 0; dc < 2; ++dc) { const u32x4 qr = *(const u32x4*)(PROJ + (size_t)tq[qs] * LDP + OFF_Q + h * 64 + dc * 32 + fq * 8); u32x4 qw;
            qw.x = cvt_pk_bf16(bflo(qr.x) * C2, bfhi(qr.x) * C2); qw.y = cvt_pk_bf16(bflo(qr.y) * C2, bfhi(qr.y) * C2); qw.z = cvt_pk_bf16(bflo(qr.z) * C2, bfhi(qr.z) * C2); qw.w = cvt_pk_bf16(bflo(qr.w) * C2, bfhi(qr.w) * C2);
            qf[qs][dc] = __builtin_bit_cast(bf16x8, qw); }
}
    for (int idx = tid; idx < 64 * IMPROW; idx += 512) impu[idx] = 0u;
    if (tid < 256) sel[tid] = 0u;
    f32x4 oacc[2][4];
    LAS f32x4* finl = (LAS f32x4*)(lds + LDS_FIN) + tid;
#pragma unroll
    for (int qs = 0; qs < 2; ++qs)
#pragma unroll
        for (int ds = 0; ds < 4; ++ds) oacc[qs][ds] = (f32x4){0.f, 0.f, 0.f, 0.f};
    __syncthreads();
    const int nct = (4 * i + 2) / 64;
    const bf16_t* kcb = KC + (size_t)g * 512 * 64; const bf16_t* vcb = VCT + (size_t)g * 512 * 64;
    float m[2] = {0.f, 0.f}, l[2] = {0.f, 0.f}; bool ini[2] = {false, false};
    const bf16_t* ksb = PROJ + OFF_KS + g * 64; const bf16_t* vsb = PROJ + OFF_VS + g * 64; const bf16_t* kwb = PROJ + OFF_KW + g * 64; const bf16_t* vwb = PROJ + OFF_VW + g * 64;
    const int wlo = (i >= 8 ? i - 8 : 0); int rslot = 0;
    branch<0>(lds, kcb, 64, vcb, 64, 0, nct, qf, i, m, l, ini, oacc, rslot, false, true, kcb, 64, vcb, 64, 0, nct);
#pragma unroll
    for (int qs = 0; qs < 2; ++qs) { const float ml = ini[qs] ? m[qs] : -INFINITY; float M = fmaxf(ml, __shfl_xor(ml, 16)); M = fmaxf(M, __shfl_xor(M, 32));
        float la = ini[qs] ? l[qs] * fexp2(m[qs] - M) : 0.f; la += __shfl_xor(la, 16); la += __shfl_xor(la, 32);
        m[qs] = la > 0.f ? -M - __builtin_amdgcn_logf(la) : -INFINITY; l[qs] = 0.f; ini[qs] = true; }
    branch<1>(lds, kcb, 64, vcb, 64, 0, nct, qf, i, m, l, ini, oacc, rslot, true, true, ksb, LDP, vsb, LDP, 0, i);
    {
        const int tl = tid >> 3, jg = tid & 7;
        unsigned key[16];
#pragma unroll
        for (int jj = 0; jj < 16; ++jj) { const int j = jg * 16 + jj; const unsigned v = impu[tl * IMPROW + j]; const bool el = (j >= 1) && (j <= i - 2); key[jj] = el ? ((v & ~127u) | (unsigned)(127 - j)) : 0u; }
        unsigned T = 0u;
        for (int bit = 31; bit >= 0; --bit) { const unsigned cand = T | (1u << bit); int c = 0;
#pragma unroll
            for (int jj = 0; jj < 16; ++jj) c += (key[jj] >= cand) ? 1 : 0;
            c += __shfl_xor(c, 1); c += __shfl_xor(c, 2); c += __shfl_xor(c, 4);
            if (c >= 13) T = cand; }
        unsigned bits = 0u;
#pragma unroll
        for (int jj = 0; jj < 16; ++jj) { const int j = jg * 16 + jj; const bool el = (j >= 1) && (j <= i - 2);
            const bool f = (j == 0) || (j == i) || (j == i - 1) || (el && key[jj] >= T); if (f) bits |= (1u << jj); }
        __hip_atomic_fetch_or(&sel[tl * 4 + (jg >> 1)], bits << ((jg & 1) * 16), __ATOMIC_RELAXED, __HIP_MEMORY_SCOPE_WORKGROUP);
    }
    __syncthreads();
#pragma unroll
    for (int qs = 0; qs < 2; ++qs) { const float g0 = ATT_GATE(qs, 0);
#pragma unroll
        for (int ds = 0; ds < 4; ++ds) { finl[(qs * 4 + ds) * 512] = oacc[qs][ds] * g0; oacc[qs][ds] = (f32x4){0.f, 0.f, 0.f, 0.f}; } }
    m[0] = 0.f; m[1] = 0.f; l[0] = 0.f; l[1] = 0.f; ini[0] = false; ini[1] = false;
    branch<2>(lds, ksb, LDP, vsb, LDP, 0, i, qf, i, m, l, ini, oacc, rslot, true, true, kwb, LDP, vwb, LDP, wlo, i);
#pragma unroll
    for (int qs = 0; qs < 2; ++qs) { float la = l[qs]; la += __shfl_xor(la, 16); la += __shfl_xor(la, 32); const float sc = ATT_GATE(qs, 1) / la;
#pragma unroll
        for (int ds = 0; ds < 4; ++ds) { finl[(qs * 4 + ds) * 512] += oacc[qs][ds] * sc; oacc[qs][ds] = (f32x4){0.f, 0.f, 0.f, 0.f}; } }
    m[0] = 0.f; m[1] = 0.f; l[0] = 0.f; l[1] = 0.f; ini[0] = false; ini[1] = false;
    branch<3>(lds, kwb, LDP, vwb, LDP, wlo, i, qf, i, m, l, ini, oacc, rslot, true, false, kwb, LDP, vwb, LDP, wlo, i);
#pragma unroll
    for (int qs = 0; qs < 2; ++qs) { float la = l[qs]; la += __shfl_xor(la, 16); la += __shfl_xor(la, 32); const float sc = ATT_GATE(qs, 2) / la;
#pragma unroll
        for (int ds = 0; ds < 4; ++ds) oacc[qs][ds] = finl[(qs * 4 + ds) * 512] + oacc[qs][ds] * sc; }
#pragma unroll
    for (int qs = 0; qs < 2; ++qs)
#pragma unroll
        for (int ds = 0; ds < 4; ++ds) { u32x2 w; w.x = cvt_pk_bf16(oacc[qs][ds][0], oacc[qs][ds][1]); w.y = cvt_pk_bf16(oacc[qs][ds][2], oacc[qs][ds][3]);
            *(u32x2*)(CO + (size_t)tq[qs] * DM + 1024 + h * 64 + ds * 16 + fq * 4) = w; }
    __syncthreads();
}
}


#define XB_TMO      128
#define XB_XCNT(j)  (256  + 64 * (j))
#define XB_XSUB(j)  (1280 + 64 * (j))
#define XB_XGEN(j)  (2304 + 64 * (j))
#define XB_TOP      3328
#define XB_TOPGEN   3392
#define XCD_BAR_WORDS 3456
#define XB_SPIN_CAP (1u << 18)
__device__ __forceinline__ unsigned xb_ld(unsigned* p)              { return __hip_atomic_load(p, __ATOMIC_RELAXED, __HIP_MEMORY_SCOPE_AGENT); }
__device__ __forceinline__ unsigned xb_add(unsigned* p, unsigned v) { return __hip_atomic_fetch_add(p, v, __ATOMIC_RELAXED, __HIP_MEMORY_SCOPE_AGENT); }
__device__ __forceinline__ unsigned xb_xcc_id() { return (unsigned)__builtin_amdgcn_s_getreg((3 << 11) | 20) & 0xFu; }
#define XB_SPIN(cond, bar) do { unsigned _sp = 0; while (cond) { __builtin_amdgcn_s_sleep(1); \
    if ((++_sp & 255u) == 0u) { if (xb_ld(&(bar)[XB_TMO])) break; if (_sp > XB_SPIN_CAP) { atomicAdd(&(bar)[XB_TMO], 1u); break; } } } } while (0)
struct XcdBarrier { unsigned* bar; unsigned x; volatile LAS unsigned* st; };
__device__ __forceinline__ XcdBarrier xcd_barrier_post(unsigned* bar, volatile LAS unsigned* st) {
    XcdBarrier b; b.bar = bar; b.x = xb_xcc_id(); b.st = st;
    if (threadIdx.x == 0) (void)xb_add(&bar[XB_XCNT(b.x)], 1u);
    return b;
}
__device__ __forceinline__ void xcd_barrier_complete(unsigned* bar, unsigned x, unsigned& nloc, unsigned& nx) {
    const unsigned G = gridDim.x * gridDim.y * gridDim.z;
    unsigned sum, cnt, mine, sp = 0u;
    for (;;) {
        sum = 0u; cnt = 0u; mine = 0u;
#pragma unroll
        for (unsigned j = 0; j < 16; ++j) { const unsigned c = xb_ld(&bar[XB_XCNT(j)]); sum += c; cnt += (c > 0u) ? 1u : 0u; mine = (j == x) ? c : mine; }
        if (sum == G) break;
        __builtin_amdgcn_s_sleep(1);
        if ((++sp & 255u) == 0u) { if (xb_ld(&bar[XB_TMO])) break; if (sp > XB_SPIN_CAP) { atomicAdd(&bar[XB_TMO], 1u); break; } }
    }
    nloc = mine > 0u ? mine : 1u; nx = cnt > 0u ? cnt : 1u;
}
__device__ __forceinline__ void xcd_barrier(const XcdBarrier& b) {
    asm volatile("s_waitcnt vmcnt(0)" ::: "memory");
    __syncthreads();
    if (threadIdx.x == 0) {
        unsigned* bar = b.bar;
        __builtin_amdgcn_s_waitcnt(0);
        unsigned nloc = b.st[0], nx = b.st[1];
        if (nloc == 0u) { xcd_barrier_complete(bar, b.x, nloc, nx); b.st[0] = nloc; b.st[1] = nx; }
        const unsigned old = xb_add(&bar[XB_XSUB(b.x)], 1u);
        const unsigned gen = old / nloc;
        if (old + 1u == (gen + 1u) * nloc) {
            __builtin_amdgcn_fence(__ATOMIC_RELEASE, "agent");
            asm volatile("s_waitcnt vmcnt(0)" ::: "memory");
            const unsigned og = xb_add(&bar[XB_TOP], 1u);
            const unsigned tg = og / nx;
            if (og + 1u == (tg + 1u) * nx) xb_add(&bar[XB_TOPGEN], 1u);
            else XB_SPIN(xb_ld(&bar[XB_TOPGEN]) == tg, bar);
            __builtin_amdgcn_fence(__ATOMIC_ACQUIRE, "agent");
            xb_add(&bar[XB_XGEN(b.x)], 1u);
            asm volatile("s_waitcnt vmcnt(0)" ::: "memory");
        } else {
            XB_SPIN(xb_ld(&bar[XB_XGEN(b.x)]) == gen, bar);
            __builtin_amdgcn_fence(__ATOMIC_ACQUIRE, "agent");
            asm volatile("s_waitcnt vmcnt(0)" ::: "memory");
        }
    }
    __syncthreads();
}

constexpr int LDS_BYTES = 139264;

__global__ void __launch_bounds__(512) mega_fwd(Args args) {
    extern __shared__ __attribute__((aligned(16))) unsigned char lds_raw[];
    LAS unsigned char* lds = (LAS unsigned char*)lds_raw;
    cg::grid_group grid = cg::this_grid();
    const int tid = threadIdx.x, lane = tid & 63, wave = __builtin_amdgcn_readfirstlane(tid >> 6);
    const int G = gridDim.x, bx = blockIdx.x;
    unsigned char* ws = args.ws;
    const float* x = args.in[0]; const float* mix_norm = args.in[1]; const float* mlp_norm = args.in[2];
    float* out = args.out;
    float* ssq = (float*)(ws + WS_SSQ);
    bf16_t* PROJ = (bf16_t*)(ws + WS_PROJ); bf16_t* XB = (bf16_t*)(ws + WS_XB); bf16_t* CO = (bf16_t*)(ws + WS_CO); bf16_t* HB = (bf16_t*)(ws + WS_H);
    bf16_t* WIN = (bf16_t*)(ws + WS_WIN); bf16_t* WOUT = (bf16_t*)(ws + WS_WOUT); bf16_t* W1 = (bf16_t*)(ws + WS_W1); bf16_t* W2 = (bf16_t*)(ws + WS_W2); bf16_t* POOLT = (bf16_t*)(ws + WS_POOLT);
    bf16_t* KC = (bf16_t*)(ws + WS_KC); bf16_t* VCT = (bf16_t*)(ws + WS_VCT); bf16_t* VTS = (bf16_t*)(ws + WS_VTS); bf16_t* VTW = (bf16_t*)(ws + WS_VTW);
    const int lo = args.ph_lo, hi = args.ph_hi;
#ifndef ONLY_PHASE
#define ONLY_PHASE -1
#endif
#define IN(k) ((ONLY_PHASE < 0 || ONLY_PHASE == (k)) && lo <= (k) && (k) < hi)
    volatile LAS unsigned* misc = (volatile LAS unsigned*)(lds + 135168);
    if (tid < 2) misc[tid] = 0u;
    __syncthreads();
    XcdBarrier xbar = xcd_barrier_post((unsigned*)(ws + WS_BAR), misc);
#define SEAM(k) do { if (IN(k) && IN((k) + 1)) { if (hi == 99 + (k)) grid.sync(); else xcd_barrier(xbar); } } while (0)

    if (IN(0)) {
        LAS float* scr = (LAS float*)(lds + wave * 16896);
        const int gw = bx * 8 + wave, NGW = G * 8;
        for (int idx = bx * 512 + tid; idx < 4 * SEQ; idx += G * 512) ssq[idx] = 0.f;
        constexpr int I_W1 = (DM / 32) * (DFF / 128), I_W2 = (DFF / 32) * (DM / 128), I_IN = (DM / 32) * (LDP / 128), I_OUT = (DM / 32) * (DM / 128), I_POOL = (512 / 32) * (512 / 128),
                      I_C1 = (2048 / 32) * 1, I_C2 = (128 / 32) * 1;
        constexpr int NITEMS = 2 * I_W1 + I_IN + I_OUT + 4 * I_POOL + 2 * I_C1 + 2 * I_C2;
#define P0_DESC(d_, it_) do { int r = (it_); \
            if (r < 2 * I_W1) { const int ly = r / I_W1; d_ = TDesc{args.in[3] + (size_t)ly * DM * DFF, W1 + (size_t)ly * DM * DFF, mlp_norm + ly * DM, DM, DFF, DFF, DFF, r % I_W1, 0}; break; } r -= 2 * I_W1; \
            if (r < I_IN) { d_ = TDesc{args.in[5], WIN, mix_norm, DM, INC, LDP, LDP, r, 1}; break; } r -= I_IN; \
            if (r < I_OUT) { d_ = TDesc{args.in[6], WOUT, nullptr, DM, DM, DM, DM, r, 0}; break; } r -= I_OUT; \
            if (r < 4 * I_POOL) { const int gi = r / I_POOL; d_ = TDesc{args.in[17] + (size_t)gi * 512 * 512, POOLT + (size_t)gi * 512 * 512, mix_norm + DM + gi * 512, 512, 512, 512, 512, r % I_POOL, 0}; break; } r -= 4 * I_POOL; \
            if (r < 2 * I_C1) { const int kv = r / I_C1; d_ = TDesc{args.in[kv ? 15 : 13], (bf16_t*)(ws + (kv ? WS_CW1V : WS_CW1K)), nullptr, 2048, 128, 128, 128, r % I_C1, 0}; break; } r -= 2 * I_C1; \
            { const int kv = r / I_C2; d_ = TDesc{args.in[kv ? 16 : 14], (bf16_t*)(ws + (kv ? WS_CW2V : WS_CW2K)), nullptr, 128, 64, 128, 64, r % I_C2, 0}; } } while (0)
        {
            f32x4 va[16], vb[16]; TDesc da{}, db{};
            int ita = gw; bool ha = ita < NITEMS;
            if (ha) { P0_DESC(da, ita); t_load(da, lane, va); }
            while (ha) {
                const int itb = ita + NGW; const bool hb = itb < NITEMS;
                if (hb) { P0_DESC(db, itb); t_load(db, lane, vb); }
                t_finish(da, lane, scr, va);
                if (!hb) break;
                ita = itb + NGW; ha = ita < NITEMS;
                if (ha) { P0_DESC(da, ita); t_load(da, lane, va); }
                t_finish(db, lane, scr, vb);
            }
        }
#undef P0_DESC
        for (int mrow = gw; mrow < SEQ; mrow += NGW) {
            const f32x4* xr = (const f32x4*)(x + (size_t)mrow * DM) + lane; f32x4 v[8]; float s = 0.f;
#pragma unroll
            for (int j = 0; j < 8; ++j) { v[j] = xr[64 * j]; s += (v[j][0] * v[j][0] + v[j][1] * v[j][1]) + (v[j][2] * v[j][2] + v[j][3] * v[j][3]); }
            const float st = wave_sum(s); if (lane == 0) ssq[4 * SEQ + mrow] = st;
            u32x2* o8 = (u32x2*)(XB + (size_t)mrow * DM) + lane;
#pragma unroll
            for (int j = 0; j < 8; ++j) { u32x2 w; w.x = cvt_pk_bf16(v[j][0], v[j][1]); w.y = cvt_pk_bf16(v[j][2], v[j][3]); o8[64 * j] = w; }
        }
        __syncthreads();
    }
    SEAM(0);
    if (IN(1)) {
        pg8::Gemm g{XB, WIN, DM, DM, DM, 0, 0}; pg8::StaticOrder S; S.init(SEQ, LDP, G, bx);
        pg8::EpiBf16 E{PROJ, LDP, 8, ssq + 4 * SEQ};
        pg8::gemm_phase<pg8::EpiBf16, pg8::StaticOrder, true>(lds, g, S, E);
        constexpr int NW3 = (SEQ / 256) * (LDP / 256) - 2 * 256;
        const int first = (G == 256) ? NW3 : 0, nidle = G - first;
        if (bx >= first) {
            LAS float* scr = (LAS float*)(lds + wave * 16896);
            constexpr int I_W2 = (DFF / 32) * (DM / 128);
            for (int it = (bx - first) * 8 + wave; it < 2 * I_W2; it += nidle * 8) { const int ly = it / I_W2;
                transpose_item(args.in[4] + (size_t)ly * DM * DFF, DFF, DM, DM, DM, W2 + (size_t)ly * DM * DFF, nullptr, scr, it % I_W2, lane); }
            __syncthreads();
        }
    }
    SEAM(1);
    if (IN(2)) {
        for (int u = bx; u < 512; u += G) conv_tile(lds, PROJ, args.in[7], args.in[8], args.in[9], args.in[10], CO, u);
        for (int u = bx; u < 256; u += G) { const int kv = u >> 7, g = (u >> 5) & 3, nt = u & 31;
            compress_unit(lds, PROJ, args.in[kv ? 12 : 11], (const bf16_t*)(ws + (kv ? WS_CW1V : WS_CW1K)), (const bf16_t*)(ws + (kv ? WS_CW2V : WS_CW2K)), kv ? VCT : KC, kv, g, nt); }
    }
    SEAM(2);
    if (IN(3)) {
        for (int u = bx; u < 256; u += G) { const int g = (u & 7) >> 1, pb = ((u >> 3) << 1) | (u & 1);
            att::unit(lds, PROJ, KC, VCT, VTS, VTW, CO, 127 - pb, g);
            att::unit(lds, PROJ, KC, VCT, VTS, VTW, CO, pb, g); }
    }
    SEAM(3);
    if (IN(4)) {
        pg8::Gemm g{CO, WOUT, DM, DM, DM, 0, 0}; pg8::StaticOrder S; S.init(SEQ, DM, G, bx);
        pg8::EpiResB<bf16_t> E{XB, XB, nullptr, ssq, nullptr, DM};
        pg8::gemm_phase<pg8::EpiResB<bf16_t>, pg8::StaticOrder, false>(lds, g, S, E);
    }
    SEAM(4);
    if (IN(5)) {
        pg8::Gemm g{XB, W1, DM, DM, DM, 0, 0}; pg8::StaticOrder S; S.init(SEQ, DFF, G, bx);
        pg8::EpiRelu2 E{HB, DFF, ssq};
        pg8::gemm_phase<pg8::EpiRelu2, pg8::StaticOrder, true>(lds, g, S, E);
    }
    SEAM(5);
    if (IN(6)) {
        pg8::Gemm g{HB, W2, DFF, DFF, DFF, 0, 0}; pg8::StaticOrder S; S.init(SEQ, DM, G, bx);
        pg8::EpiResB<bf16_t> E{XB, XB, nullptr, ssq + SEQ, nullptr, DM};
        pg8::gemm_phase<pg8::EpiResB<bf16_t>, pg8::StaticOrder, false>(lds, g, S, E);
    }
    SEAM(6);
    if (IN(8)) {
        pg8::Gemm g{XB, POOLT, DM, 512, 512, 1, 1024}; pg8::StaticOrder S; S.init(SEQ, DM, G, bx);
        if (G == 256) { pg8::EpiPool E{XB, ssq + SEQ, ssq + 2 * SEQ, args.in[18], (unsigned long long*)(ws + WS_CO), (unsigned*)(ws + WS_BAR + 24576), DM, lds};
            pg8::gemm_phase<pg8::EpiPool, pg8::StaticOrder, false>(lds, g, S, E); }
    }
    SEAM(8);
    if (IN(9)) {
        pg8::Gemm g{XB, W1 + (size_t)DM * DFF, DM, DM, DM, 0, 0}; pg8::StaticOrder S; S.init(SEQ, DFF, G, bx);
        pg8::EpiRelu2 E{HB, DFF, ssq + 2 * SEQ};
        pg8::gemm_phase<pg8::EpiRelu2, pg8::StaticOrder, true>(lds, g, S, E);
    }
    SEAM(9);
    if (IN(10)) {
        pg8::Gemm g{HB, W2 + (size_t)DM * DFF, DFF, DFF, DFF, 0, 0}; pg8::StaticOrder S; S.init(SEQ, DM, G, bx);
        if (G == 256) { pg8::EpiFinal E{XB, out, ssq + 3 * SEQ, (unsigned*)(ws + WS_BAR + 16384), args.in[19], DM};
            pg8::gemm_phase<pg8::EpiFinal, pg8::StaticOrder, false>(lds, g, S, E); }
        else { pg8::EpiResB<bf16_t> E{XB, nullptr, out, ssq + 3 * SEQ, nullptr, DM};
            pg8::gemm_phase<pg8::EpiResB<bf16_t>, pg8::StaticOrder, false>(lds, g, S, E); }
    }
    if (G != 256) SEAM(10);
    if (IN(11) && G != 256) {
        const float* ss = ssq + 3 * SEQ; const float* fg = args.in[19];
        const int c = tid * 4; const f32x4 gg = *(const f32x4*)(fg + c);
        for (int t0 = bx * 8; t0 < SEQ; t0 += G * 8) {
            f32x4 v[8]; float rr[8];
#pragma unroll
            for (int j = 0; j < 8; ++j) { v[j] = *(const f32x4*)(out + (size_t)(t0 + j) * DM + c); rr[j] = ss[t0 + j]; }
#pragma unroll
            for (int j = 0; j < 8; ++j) *(f32x4*)(out + (size_t)(t0 + j) * DM + c) = v[j] * __builtin_amdgcn_rsqf(rr[j] * (1.f / DM) + EPS) * gg;
        }
    }
    if (IN(12)) {
#if DIGEST_AFTER == 1
        for (int idx = bx * 512 + tid; idx < SEQ * DM; idx += G * 512) { const int t = idx >> 11, c = idx & 2047; const bf16_t* pr = PROJ + (size_t)t * LDP;
            out[idx] = bf2f(pr[c]) + bf2f(pr[c + 2048]) + (c + 4096 < INC ? bf2f(pr[c + 4096]) : 0.f); }
#elif DIGEST_AFTER == 2
        for (int idx = bx * 512 + tid; idx < SEQ * DM; idx += G * 512) { const int t = idx >> 11, c = idx & 2047; float v;
            if (c < 1024) v = bf2f(CO[idx]);
            else v = 0.f;
            out[idx] = v; }
#else
        for (int idx = bx * 512 + tid; idx < SEQ * DM; idx += G * 512) out[idx] = bf2f(CO[idx]);
#endif
    }
#undef IN
#undef SEAM
}

extern "C" void kernel_launch(void* const* d_in, const int* in_sizes, int n_in, void* d_out, int out_size, void* d_ws, size_t ws_size, hipStream_t stream) {
    static int grid = 0;
    if (grid == 0) {
        if (n_in != 20 || out_size != SEQ * DM || ws_size < WS_END) { fprintf(stderr, "kernel_launch: unexpected shapes (n_in %d out %d ws %zu)\n", n_in, out_size, ws_size); grid = -1; return; }
        int dev = 0, cus = 0, per_cu = 0;
        (void)hipGetDevice(&dev); (void)hipDeviceGetAttribute(&cus, hipDeviceAttributeMultiprocessorCount, dev);
        if (hipFuncSetAttribute((const void*)mega_fwd, hipFuncAttributeMaxDynamicSharedMemorySize, LDS_BYTES) != hipSuccess) { fprintf(stderr, "kernel_launch: hipFuncSetAttribute failed\n"); grid = -1; return; }
        if (hipOccupancyMaxActiveBlocksPerMultiprocessor(&per_cu, (const void*)mega_fwd, 512, LDS_BYTES) != hipSuccess || per_cu < 1) { fprintf(stderr, "kernel_launch: occupancy query failed (%d)\n", per_cu); per_cu = 1; }
        (void)hipGetLastError();
        grid = cus * (per_cu > 1 ? 1 : per_cu);
        if (grid > 256) grid = 256;
    }
    if (grid < 0) return;
    if (hipMemsetAsync((char*)d_ws + WS_BAR, 0, 40960, stream) != hipSuccess) { fprintf(stderr, "kernel_launch: memset of the barrier words failed\n"); return; }
    Args a{};
    for (int i = 0; i < 20; ++i) a.in[i] = (const float*)d_in[i];
    a.out = (float*)d_out; a.ws = (unsigned char*)d_ws;
#if MK_LAUNCHES == 1
    a.ph_lo = 0; a.ph_hi = 12;
    void* kargs[] = {&a};
    hipError_t e = hipLaunchCooperativeKernel((const void*)mega_fwd, dim3(grid), dim3(512), kargs, LDS_BYTES, stream);
    if (e != hipSuccess) fprintf(stderr, "cooperative launch failed: %s (grid %d)\n", hipGetErrorString(e), grid);
#else
#ifdef DIGEST_AFTER
    for (int p = 0; p <= DIGEST_AFTER; ++p) { a.ph_lo = p; a.ph_hi = p + 1; hipLaunchKernelGGL(mega_fwd, dim3(grid), dim3(512), LDS_BYTES, stream, a); }
    a.ph_lo = 12; a.ph_hi = 13; hipLaunchKernelGGL(mega_fwd, dim3(grid), dim3(512), LDS_BYTES, stream, a);
#else
    for (int p = 0; p < 12; ++p) { a.ph_lo = p; a.ph_hi = p + 1; hipLaunchKernelGGL(mega_fwd, dim3(grid), dim3(512), LDS_BYTES, stream, a); }
#endif
#endif
}
```

```cpp
#include <hip/hip_runtime.h>
#include <hip/hip_cooperative_groups.h>
#include <cstdio>
#include <cstdint>
namespace cg = cooperative_groups;

#ifndef MK_LAUNCHES
#define MK_LAUNCHES 1
#endif

#define LAS __attribute__((address_space(3)))
typedef unsigned short bf16_t;
typedef short bf16x8 __attribute__((ext_vector_type(8)));
typedef float f32x4 __attribute__((ext_vector_type(4)));
typedef float f32x2 __attribute__((ext_vector_type(2)));
typedef unsigned u32x4 __attribute__((ext_vector_type(4)));
typedef unsigned u32x2 __attribute__((ext_vector_type(2)));
typedef short v4i16_t __attribute__((ext_vector_type(4)));

typedef __bf16 bf16x2_t __attribute__((ext_vector_type(2)));
__device__ __forceinline__ unsigned cvt_pk_bf16(float lo, float hi) { f32x2 v = {lo, hi}; bf16x2_t b = __builtin_convertvector(v, bf16x2_t); return __builtin_bit_cast(unsigned, b); }
__device__ __forceinline__ float bf2f(unsigned short b) { return __uint_as_float(((unsigned)b) << 16); }
__device__ __forceinline__ float bflo(unsigned w) { return __uint_as_float(w << 16); }
__device__ __forceinline__ float bfhi(unsigned w) { return __uint_as_float(w & 0xffff0000u); }
__device__ __forceinline__ float fexp2(float x) { return __builtin_amdgcn_exp2f(x); }
__device__ __forceinline__ float sigmoidf_(float x) { return 1.0f / (1.0f + __expf(-x)); }

constexpr int SEQ = 8192, DM = 2048, DFF = 8192, LDP = 4864  , INC = 4656;
constexpr int OFF_A = 0, OFF_GT = 1024, OFF_Q = 2048, OFF_KC = 3072, OFF_VC = 3328, OFF_KS = 3584, OFF_VS = 3840, OFF_KW = 4096, OFF_VW = 4352, OFF_GL = 4608;
constexpr float EPS = 1e-6f;

constexpr size_t MiB = 1u << 20;
constexpr size_t WS_SSQ = 0;
constexpr size_t WS_BAR = 256 * 1024;
constexpr size_t WS_CW1K = 1 * MiB, WS_CW1V = 1 * MiB + 512 * 1024, WS_CW2K = 2 * MiB, WS_CW2V = 2 * MiB + 64 * 1024;
constexpr size_t WS_KC = 3 * MiB, WS_VCT = 3 * MiB + 512 * 1024;
constexpr size_t WS_POOLT = 4 * MiB, WS_VTS = 6 * MiB, WS_VTW = 10 * MiB, WS_WOUT = 14 * MiB, WS_WIN = 22 * MiB;
constexpr size_t WS_W1 = 42 * MiB, WS_W2 = 106 * MiB, WS_XB = 170 * MiB, WS_CO = 202 * MiB, WS_PROJ = 234 * MiB, WS_H = 310 * MiB, WS_END = 438 * MiB;

namespace pg8 {
constexpr int BM = 256, BK = 64, HALF = 128, HTB = HALF * BK * 2, STAGE_BYTES = 8 * HTB, NXCD = 8, WGM = 8;
__host__ __device__ __forceinline__ int lds_byte(int r, int c) { const int st = (r >> 4) * 2 + (c >> 5), rr = r & 15, cc = c & 31, ob = rr * 64 + cc * 2; return st * 1024 + (ob ^ (((ob >> 9) & 1) << 5)); }
__host__ __device__ __forceinline__ void stage_rc(int b, int& R, int& C) { const int st = b / 1024, sb = b % 1024, swz = sb ^ (((sb >> 9) & 1) << 5); R = (st >> 1) * 16 + swz / 64; C = (st & 1) * 32 + (swz % 64) / 2; }
__host__ __device__ __forceinline__ int perm32(int rho) { const int n = rho >> 4, i = rho & 15; return 8 * (i >> 2) + 4 * n + (i & 3); }
struct Unit { int pm, pn; };
struct Gemm { const bf16_t* A; const bf16_t* Bt; int lda, ldb, K, a_pn_shift, a_pn_bytes; };
struct StaticOrder {
    int nM, nN, nwg, G, c;
    __host__ __device__ void init(int M, int N, int G_, int c_) { nM = M / BM; nN = N / BM; nwg = nM * nN; G = G_; c = c_; }
    __host__ __device__ bool next(int i, Unit& u) const {
        const long L = (long)i * G + c; if (L >= nwg) return false;
        int wgid = (int)L; { const int q = nwg / NXCD, r = nwg % NXCD, xcd = wgid % NXCD, off = wgid / NXCD; wgid = (xcd < r ? xcd * (q + 1) : r * (q + 1) + (xcd - r) * q) + off; }
        const int nig = WGM * nN, gid = wgid / nig, fm = gid * WGM, gsz = (nM - fm) < WGM ? (nM - fm) : WGM;
        u.pm = fm + ((wgid % nig) % gsz); u.pn = (wgid % nig) / gsz; return true;
    }
};
struct EpiBf16 {
    static constexpr bool PERM = true, AFTER_DRAIN = false;
    bf16_t* O; int ldc; int glu_tiles; const float* ssq;
    __device__ __forceinline__ void operator()(const f32x4 (&acc)[2][2][4][2], const Unit& u, int wr, int wc, int fr, int fq) const {
        const int row0 = u.pm * BM + wr * 64 + fr, col0 = u.pn * BM + wc * 32 + 8 * fq;
        if (u.pn < glu_tiles) {
#pragma unroll
            for (int ai = 0; ai < 2; ++ai)
#pragma unroll
                for (int m = 0; m < 4; ++m) { const int row = row0 + ai * HALF + m * 16; bf16_t* rowp = O + (size_t)row * ldc + col0; const float r = __builtin_amdgcn_rsqf(ssq[row] * (1.0f / 2048.0f) + EPS);
                    f32x4 v0 = acc[ai][0][m][0] * r, v1 = acc[ai][0][m][1] * r; const f32x4 g0 = acc[ai][1][m][0] * r, g1 = acc[ai][1][m][1] * r;
#pragma unroll
                    for (int e = 0; e < 4; ++e) { v0[e] *= sigmoidf_(g0[e]); v1[e] *= sigmoidf_(g1[e]); }
                    u32x4 w; w.x = cvt_pk_bf16(v0[0], v0[1]); w.y = cvt_pk_bf16(v0[2], v0[3]); w.z = cvt_pk_bf16(v1[0], v1[1]); w.w = cvt_pk_bf16(v1[2], v1[3]);
                    *(u32x4*)rowp = w; }
            return;
        }
#pragma unroll
        for (int ai = 0; ai < 2; ++ai)
#pragma unroll
            for (int m = 0; m < 4; ++m) { const int row = row0 + ai * HALF + m * 16; bf16_t* rowp = O + (size_t)row * ldc + col0; const float r = __builtin_amdgcn_rsqf(ssq[row] * (1.0f / 2048.0f) + EPS);
#pragma unroll
                for (int bj = 0; bj < 2; ++bj) { const f32x4 v0 = acc[ai][bj][m][0] * r, v1 = acc[ai][bj][m][1] * r;
                    u32x4 w; w.x = cvt_pk_bf16(v0[0], v0[1]); w.y = cvt_pk_bf16(v0[2], v0[3]); w.z = cvt_pk_bf16(v1[0], v1[1]); w.w = cvt_pk_bf16(v1[2], v1[3]);
                    *(u32x4*)(rowp + bj * HALF) = w; } }
    }
};
struct EpiRelu2 {
    static constexpr bool PERM = true, AFTER_DRAIN = false;
    bf16_t* O; int ldc; const float* ssq;
    __device__ __forceinline__ void operator()(const f32x4 (&acc)[2][2][4][2], const Unit& u, int wr, int wc, int fr, int fq) const {
        const int row0 = u.pm * BM + wr * 64 + fr, col0 = u.pn * BM + wc * 32 + 8 * fq;
#pragma unroll
        for (int ai = 0; ai < 2; ++ai)
#pragma unroll
            for (int m = 0; m < 4; ++m) { const int row = row0 + ai * HALF + m * 16; bf16_t* rowp = O + (size_t)row * ldc + col0;
                const float r = __builtin_amdgcn_rsqf(ssq[row] * (1.0f / 2048.0f) + EPS);
#pragma unroll
                for (int bj = 0; bj < 2; ++bj) { f32x4 v0 = acc[ai][bj][m][0] * r, v1 = acc[ai][bj][m][1] * r;
#pragma unroll
                    for (int e = 0; e < 4; ++e) { const float a = fmaxf(v0[e], 0.f), b = fmaxf(v1[e], 0.f); v0[e] = a * a; v1[e] = b * b; }
                    u32x4 w; w.x = cvt_pk_bf16(v0[0], v0[1]); w.y = cvt_pk_bf16(v0[2], v0[3]); w.z = cvt_pk_bf16(v1[0], v1[1]); w.w = cvt_pk_bf16(v1[2], v1[3]);
                    *(u32x4*)(rowp + bj * HALF) = w; } }
    }
};
struct EpiRes {
    static constexpr bool PERM = false, AFTER_DRAIN = false;
    const float* base; float* out; bf16_t* outb; float* ssq; const float* colscale; int ldc;
    __device__ __forceinline__ void operator()(const f32x4 (&acc)[2][2][4][2], const Unit& u, int wr, int wc, int fr, int fq) const {
        const int col0 = u.pn * BM + wc * 32 + 4 * fq;
        f32x4 cs[2][2];
#pragma unroll
        for (int bj = 0; bj < 2; ++bj)
#pragma unroll
            for (int n = 0; n < 2; ++n) cs[bj][n] = colscale ? *(const f32x4*)(colscale + col0 + bj * HALF + n * 16) : (f32x4){1.f, 1.f, 1.f, 1.f};
#pragma unroll
        for (int ai = 0; ai < 2; ++ai)
#pragma unroll
            for (int m = 0; m < 4; ++m) { const int row = u.pm * BM + ai * HALF + wr * 64 + m * 16 + fr; const size_t off = (size_t)row * ldc + col0; float s = 0.f;
#pragma unroll
                for (int bj = 0; bj < 2; ++bj)
#pragma unroll
                    for (int n = 0; n < 2; ++n) { const f32x4 b = *(const f32x4*)(base + off + bj * HALF + n * 16); const f32x4 o = b + acc[ai][bj][m][n] * cs[bj][n];
                        *(f32x4*)(out + off + bj * HALF + n * 16) = o;
                        if (outb) { u32x2 w; w.x = cvt_pk_bf16(o[0], o[1]); w.y = cvt_pk_bf16(o[2], o[3]); *(u32x2*)(outb + off + bj * HALF + n * 16) = w; }
                        s += (o[0] * o[0] + o[1] * o[1]) + (o[2] * o[2] + o[3] * o[3]); }
                if (ssq) { s += __shfl_xor(s, 16); s += __shfl_xor(s, 32); if (fq == 0) atomicAdd(ssq + row, s); } }
    }
};

__device__ __forceinline__ void ld8(const float* p, f32x4& a, f32x4& b) { a = *(const f32x4*)p; b = *(const f32x4*)(p + 4); }
__device__ __forceinline__ void ld8(const bf16_t* p, f32x4& a, f32x4& b) { const u32x4 w = *(const u32x4*)p; a = (f32x4){bflo(w.x), bfhi(w.x), bflo(w.y), bfhi(w.y)}; b = (f32x4){bflo(w.z), bfhi(w.z), bflo(w.w), bfhi(w.w)}; }
template <class BT>
struct EpiResB {
    static constexpr bool PERM = true, AFTER_DRAIN = false;
    const BT* base; bf16_t* outb; float* outf; float* ssq; const float* colscale; int ldc;
    __device__ __forceinline__ void operator()(const f32x4 (&acc)[2][2][4][2], const Unit& u, int wr, int wc, int fr, int fq) const {
        const int row0 = u.pm * BM + wr * 64 + fr, col0 = u.pn * BM + wc * 32 + 8 * fq;
        f32x4 cs[2][2];
#pragma unroll
        for (int bj = 0; bj < 2; ++bj)
#pragma unroll
            for (int n = 0; n < 2; ++n) cs[bj][n] = colscale ? *(const f32x4*)(colscale + col0 + bj * HALF + 4 * n) : (f32x4){1.f, 1.f, 1.f, 1.f};
        u32x4 raw[2][4][2];
        if constexpr (sizeof(BT) == 2) {
#pragma unroll
            for (int ai = 0; ai < 2; ++ai)
#pragma unroll
                for (int m = 0; m < 4; ++m)
#pragma unroll
                    for (int bj = 0; bj < 2; ++bj) raw[ai][m][bj] = *(const u32x4*)((const bf16_t*)base + (size_t)(row0 + ai * HALF + m * 16) * ldc + col0 + bj * HALF);
        }
#pragma unroll
        for (int ai = 0; ai < 2; ++ai)
#pragma unroll
            for (int m = 0; m < 4; ++m) { const int row = row0 + ai * HALF + m * 16; const size_t off = (size_t)row * ldc + col0; float s = 0.f;
#pragma unroll
                for (int bj = 0; bj < 2; ++bj) { f32x4 b0, b1;
                    if constexpr (sizeof(BT) == 2) { const u32x4 w_ = raw[ai][m][bj]; b0 = (f32x4){bflo(w_.x), bfhi(w_.x), bflo(w_.y), bfhi(w_.y)}; b1 = (f32x4){bflo(w_.z), bfhi(w_.z), bflo(w_.w), bfhi(w_.w)}; }
                    else ld8(base + off + bj * HALF, b0, b1);
                    const f32x4 o0 = b0 + acc[ai][bj][m][0] * cs[bj][0], o1 = b1 + acc[ai][bj][m][1] * cs[bj][1];
                    s += ((o0[0] * o0[0] + o0[1] * o0[1]) + (o0[2] * o0[2] + o0[3] * o0[3])) + ((o1[0] * o1[0] + o1[1] * o1[1]) + (o1[2] * o1[2] + o1[3] * o1[3]));
                    if (outb) { u32x4 w; w.x = cvt_pk_bf16(o0[0], o0[1]); w.y = cvt_pk_bf16(o0[2], o0[3]); w.z = cvt_pk_bf16(o1[0], o1[1]); w.w = cvt_pk_bf16(o1[2], o1[3]); *(u32x4*)(outb + off + bj * HALF) = w; }
                    if (outf) { *(f32x4*)(outf + off + bj * HALF) = o0; *(f32x4*)(outf + off + bj * HALF + 4) = o1; } }
                if (ssq) { s += __shfl_xor(s, 16); s += __shfl_xor(s, 32); if (fq == 0) atomicAdd(ssq + row, s); } }
    }
};
struct EpiFinal {
    static constexpr bool PERM = true, AFTER_DRAIN = true;
    const bf16_t* base; float* out; float* ssq; unsigned* cnt; const float* gcol; int ldc;
    __device__ __forceinline__ void operator()(f32x4 (&acc)[2][2][4][2], const Unit& u, int wr, int wc, int fr, int fq) const {
        const int row0 = u.pm * BM + wr * 64 + fr, col0 = u.pn * BM + wc * 32 + 8 * fq;
        u32x4 rawf[2][4][2];
#pragma unroll
        for (int ai = 0; ai < 2; ++ai)
#pragma unroll
            for (int m = 0; m < 4; ++m)
#pragma unroll
                for (int bj = 0; bj < 2; ++bj) rawf[ai][m][bj] = *(const u32x4*)(base + (size_t)(row0 + ai * HALF + m * 16) * ldc + col0 + bj * HALF);
#pragma unroll
        for (int ai = 0; ai < 2; ++ai)
#pragma unroll
            for (int m = 0; m < 4; ++m) { const int row = row0 + ai * HALF + m * 16; float s = 0.f;
#pragma unroll
                for (int bj = 0; bj < 2; ++bj) { const u32x4 w_ = rawf[ai][m][bj]; const f32x4 b0 = (f32x4){bflo(w_.x), bfhi(w_.x), bflo(w_.y), bfhi(w_.y)}, b1 = (f32x4){bflo(w_.z), bfhi(w_.z), bflo(w_.w), bfhi(w_.w)};
                    const f32x4 o0 = b0 + acc[ai][bj][m][0], o1 = b1 + acc[ai][bj][m][1]; acc[ai][bj][m][0] = o0; acc[ai][bj][m][1] = o1;
                    s += ((o0[0] * o0[0] + o0[1] * o0[1]) + (o0[2] * o0[2] + o0[3] * o0[3])) + ((o1[0] * o1[0] + o1[1] * o1[1]) + (o1[2] * o1[2] + o1[3] * o1[3])); }
                s += __shfl_xor(s, 16); s += __shfl_xor(s, 32); if (fq == 0) atomicAdd(ssq + row, s); }
        asm volatile("s_waitcnt vmcnt(0)" ::: "memory"); __syncthreads();
        if (threadIdx.x == 0) {
            unsigned* c = cnt + 64 * u.pm;
            __hip_atomic_fetch_add(c, 1u, __ATOMIC_RELEASE, __HIP_MEMORY_SCOPE_AGENT);
            unsigned sp = 0u;
            while (__hip_atomic_load(c, __ATOMIC_RELAXED, __HIP_MEMORY_SCOPE_AGENT) < 8u) { __builtin_amdgcn_s_sleep(2); if (++sp > (1u << 22)) break; }
            __builtin_amdgcn_fence(__ATOMIC_ACQUIRE, "agent");
        }
        __syncthreads();
        f32x4 gg[2][2];
#pragma unroll
        for (int bj = 0; bj < 2; ++bj)
#pragma unroll
            for (int n = 0; n < 2; ++n) gg[bj][n] = *(const f32x4*)(gcol + col0 + bj * HALF + 4 * n);
#pragma unroll
        for (int ai = 0; ai < 2; ++ai)
#pragma unroll
            for (int m = 0; m < 4; ++m) { const int row = row0 + ai * HALF + m * 16; const size_t off = (size_t)row * ldc + col0;
                const float r = __builtin_amdgcn_rsqf(__hip_atomic_load(ssq + row, __ATOMIC_RELAXED, __HIP_MEMORY_SCOPE_AGENT) * (1.0f / 2048.0f) + EPS);
#pragma unroll
                for (int bj = 0; bj < 2; ++bj) { *(f32x4*)(out + off + bj * HALF) = acc[ai][bj][m][0] * r * gg[bj][0]; *(f32x4*)(out + off + bj * HALF + 4) = acc[ai][bj][m][1] * r * gg[bj][1]; } }
    }
};

struct EpiPool {
    static constexpr bool PERM = true, AFTER_DRAIN = true;
    bf16_t* xb; const float* ssq_in; float* ssq_out; const float* colscale; unsigned long long* zh; unsigned* flag; int ldc; LAS unsigned char* lds;
    template <int W>
    __device__ __forceinline__ void slide(LAS bf16_t* zt, int tid, int rowT) const {
        const int col = tid & 127, q = tid >> 7; LAS bf16_t* zc = zt + col;
        const int r0 = 64 * q;
        float ring[W]; float s = 0.f;
#pragma unroll
        for (int n = 1; n < W; ++n) { ring[n] = bf2f(zc[(16 + r0 - W + n) * 136]); s += ring[n]; }
        ring[0] = 0.f;
        __syncthreads();
        for (int t0 = 0; t0 < 64; t0 += 16) {
            float zv[16];
#pragma unroll
            for (int j = 0; j < 16; ++j) zv[j] = bf2f(zc[(16 + r0 + t0 + j) * 136]);
#pragma unroll
            for (int j = 0; j < 16; ++j) { const int rr = r0 + t0 + j; const float z = zv[j]; ring[j % W] = z; s += z;
                const int gt = rowT + rr; const float cnt = (float)((gt + 1 < W) ? gt + 1 : W);
                const float y = s / cnt - z;
                zc[(16 + rr) * 136] = (bf16_t)(cvt_pk_bf16(y, 0.f) & 0xffffu);
                s -= ring[(j + 1) % W]; }
        }
    }
    __device__ __forceinline__ void operator()(const f32x4 (&acc)[2][2][4][2], const Unit& u, int wr, int wc, int fr, int fq) const {
        const int tid = threadIdx.x, w = 2 << (u.pn >> 1), rowT = u.pm * BM, unit = u.pm * 8 + u.pn;
        LAS bf16_t* zt = (LAS bf16_t*)lds;
        LAS float* rl = (LAS float*)(lds + 272 * 272);
        if (tid < 272) { const int gr = rowT - 16 + tid; rl[tid] = gr >= 0 ? __builtin_amdgcn_rsqf(ssq_in[gr] * (1.0f / 2048.0f) + EPS) : 0.f; }
        __syncthreads();
        const int hr = tid >> 5, g4 = tid & 31;
#pragma unroll
        for (int bj = 0; bj < 2; ++bj) {
#pragma unroll
            for (int ai = 0; ai < 2; ++ai)
#pragma unroll
                for (int m = 0; m < 4; ++m) { const int trow = ai * HALF + wr * 64 + m * 16 + fr; const float r = rl[16 + trow];
                    const f32x4 v0 = acc[ai][bj][m][0] * r, v1 = acc[ai][bj][m][1] * r;
                    u32x4 pk; pk.x = cvt_pk_bf16(v0[0], v0[1]); pk.y = cvt_pk_bf16(v0[2], v0[3]); pk.z = cvt_pk_bf16(v1[0], v1[1]); pk.w = cvt_pk_bf16(v1[2], v1[3]);
                    *(LAS u32x4*)(zt + (16 + trow) * 136 + wc * 32 + fq * 8) = pk; }
            __syncthreads();
            { const u32x2 v = *(const LAS u32x2*)(zt + (16 + 240 + hr) * 136 + g4 * 4);
              __hip_atomic_store(zh + ((size_t)unit * 16 + hr) * 64 + bj * 32 + g4, (unsigned long long)v.x | ((unsigned long long)v.y << 32), __ATOMIC_RELAXED, __HIP_MEMORY_SCOPE_AGENT); }
            asm volatile("s_waitcnt vmcnt(0)" ::: "memory"); __syncthreads();
            if (tid == 0) {
                __hip_atomic_fetch_add(flag + unit * 16, 1u, __ATOMIC_RELEASE, __HIP_MEMORY_SCOPE_AGENT);
                if (u.pm > 0) { unsigned sp = 0u; while (__hip_atomic_load(flag + (unit - 8) * 16, __ATOMIC_RELAXED, __HIP_MEMORY_SCOPE_AGENT) < (unsigned)(bj + 1)) { __builtin_amdgcn_s_sleep(2); if (++sp > (1u << 22)) break; }
                    __builtin_amdgcn_fence(__ATOMIC_ACQUIRE, "agent"); }
            }
            __syncthreads();
            { unsigned long long hv = 0ull;
              if (u.pm > 0) hv = __hip_atomic_load(zh + ((size_t)(unit - 8) * 16 + hr) * 64 + bj * 32 + g4, __ATOMIC_RELAXED, __HIP_MEMORY_SCOPE_AGENT);
              *(LAS u32x2*)(zt + hr * 136 + g4 * 4) = (u32x2){(unsigned)hv, (unsigned)(hv >> 32)}; }
            __syncthreads();
            if (w == 2) slide<2>(zt, tid, rowT); else if (w == 4) slide<4>(zt, tid, rowT); else if (w == 8) slide<8>(zt, tid, rowT); else slide<16>(zt, tid, rowT);
            __syncthreads();
            const int row0 = rowT + wr * 64 + fr, col0 = u.pn * BM + bj * HALF + wc * 32 + 8 * fq;
            const f32x4 cs0 = *(const f32x4*)(colscale + col0), cs1 = *(const f32x4*)(colscale + col0 + 4);
            u32x4 rawp[2][4];
#pragma unroll
            for (int ai = 0; ai < 2; ++ai)
#pragma unroll
                for (int m = 0; m < 4; ++m) rawp[ai][m] = *(const u32x4*)(xb + (size_t)(rowT + ai * HALF + wr * 64 + m * 16 + fr) * ldc + col0);
#pragma unroll
            for (int ai = 0; ai < 2; ++ai)
#pragma unroll
                for (int m = 0; m < 4; ++m) { const int trow = ai * HALF + wr * 64 + m * 16 + fr, row = rowT + trow; const size_t off = (size_t)row * ldc + col0;
                    const u32x4 yw = *(const LAS u32x4*)(zt + (16 + trow) * 136 + wc * 32 + fq * 8);
                    const f32x4 y0 = (f32x4){bflo(yw.x), bfhi(yw.x), bflo(yw.y), bfhi(yw.y)}, y1 = (f32x4){bflo(yw.z), bfhi(yw.z), bflo(yw.w), bfhi(yw.w)};
                    const u32x4 w_ = rawp[ai][m]; const f32x4 b0 = (f32x4){bflo(w_.x), bfhi(w_.x), bflo(w_.y), bfhi(w_.y)}, b1 = (f32x4){bflo(w_.z), bfhi(w_.z), bflo(w_.w), bfhi(w_.w)};
                    const f32x4 o0 = b0 + y0 * cs0, o1 = b1 + y1 * cs1;
                    float sq = ((o0[0] * o0[0] + o0[1] * o0[1]) + (o0[2] * o0[2] + o0[3] * o0[3])) + ((o1[0] * o1[0] + o1[1] * o1[1]) + (o1[2] * o1[2] + o1[3] * o1[3]));
                    u32x4 ow; ow.x = cvt_pk_bf16(o0[0], o0[1]); ow.y = cvt_pk_bf16(o0[2], o0[3]); ow.z = cvt_pk_bf16(o1[0], o1[1]); ow.w = cvt_pk_bf16(o1[2], o1[3]); *(u32x4*)(xb + off) = ow;
                    sq += __shfl_xor(sq, 16); sq += __shfl_xor(sq, 32); if (fq == 0) atomicAdd(ssq_out + row, sq); }
            (void)row0;
            __syncthreads();
        }
    }
};

template <class Epi, class Sched, bool ALIGN_EPI>
__device__ __forceinline__ void gemm_phase(LAS unsigned char* lds, const Gemm g, const Sched& S, const Epi& E) {
    const int tid = threadIdx.x, wid = __builtin_amdgcn_readfirstlane(tid >> 6), lane = tid & 63, wr = wid >> 2, wc = wid & 3, fr = lane & 15, fq = lane >> 4;
    const int K = g.K, nt = K / BK;
    unsigned voffA[2], voffB[2];
#pragma unroll
    for (int i = 0; i < 2; ++i) { int R, C; stage_rc(tid * 16 + i * 8192, R, C); const int Rb = Epi::PERM ? ((R & ~31) + perm32(R & 31)) : R;
        voffA[i] = (unsigned)(R * g.lda + C) * 2u; voffB[i] = (unsigned)(Rb * g.ldb + C) * 2u; }
    const size_t kstep = (size_t)(BK * 2);
    const size_t hstepA = (size_t)HALF * g.lda * 2, hstepB = (size_t)HALF * g.ldb * 2;
    const size_t tstepA = 2 * hstepA, tstepB = 2 * hstepB;
    const unsigned ldsw = (unsigned)wid * 1024u;
    const int aoff = lds_byte(wr * 64 + fr, fq * 8), boff = lds_byte(wc * 32 + fr, fq * 8);
#define PG8_UA(u) ((const char*)g.A + (size_t)(u).pm * tstepA + (size_t)((u).pn >> g.a_pn_shift) * (size_t)g.a_pn_bytes)
#define PG8_UB(u) ((const char*)g.Bt + (size_t)(u).pn * tstepB)
#define PG8_SA(b, h) (((b) * 2 + (h)) * HTB)
#define PG8_SB(b, h) ((4 + (b) * 2 + (h)) * HTB)
#define PG8_STAGE(bufoff, gbase, voff) do { _Pragma("unroll") for (int _i = 0; _i < 2; ++_i) \
        __builtin_amdgcn_global_load_lds((const unsigned*)((const char*)(gbase) + (voff)[_i]), (LAS unsigned*)(lds + (bufoff) + ldsw + _i * 8192), 16, 0, 0); } while (0)
#define PG8_LDA(dst, b, h) do { _Pragma("unroll") for (int m = 0; m < 4; ++m) _Pragma("unroll") for (int k = 0; k < 2; ++k) dst[m][k] = *(const LAS bf16x8*)(lds + PG8_SA(b, h) + aoff + m * 2048 + k * 1024); } while (0)
#define PG8_LDB(dst, b, h) do { _Pragma("unroll") for (int n = 0; n < 2; ++n) _Pragma("unroll") for (int k = 0; k < 2; ++k) dst[n][k] = *(const LAS bf16x8*)(lds + PG8_SB(b, h) + boff + n * 2048 + k * 1024); } while (0)
#define PG8_MMA(ai, bj, At, Bt) do { __builtin_amdgcn_s_setprio(1); _Pragma("unroll") for (int m = 0; m < 4; ++m) _Pragma("unroll") for (int n = 0; n < 2; ++n) _Pragma("unroll") for (int k = 0; k < 2; ++k) \
        acc[ai][bj][m][n] = __builtin_amdgcn_mfma_f32_16x16x32_bf16(Bt[n][k], At[m][k], acc[ai][bj][m][n], 0, 0, 0); __builtin_amdgcn_s_setprio(0); } while (0)
#define PG8_WAIT_V(n) asm volatile("s_waitcnt vmcnt(" #n ")" ::: "memory")
#define PG8_WAIT_L(n) asm volatile("s_waitcnt lgkmcnt(" #n ")" ::: "memory")
#define PG8_BAR __builtin_amdgcn_s_barrier()
#define PG8_SCHED __builtin_amdgcn_sched_barrier(0)
    Unit cur, nxt; int ui = 0;
    if (!S.next(0, cur)) return;
    f32x4 acc[2][2][4][2];
#pragma unroll
    for (int a = 0; a < 2; ++a)
#pragma unroll
        for (int b = 0; b < 2; ++b)
#pragma unroll
            for (int m = 0; m < 4; ++m)
#pragma unroll
                for (int n = 0; n < 2; ++n) acc[a][b][m][n] = (f32x4){0.f, 0.f, 0.f, 0.f};
    bf16x8 At[4][2], B0[2][2], B1[2][2];
    const char* cA = PG8_UA(cur); const char* cB = PG8_UB(cur);
    PG8_STAGE(PG8_SB(0, 0), cB, voffB); PG8_STAGE(PG8_SB(0, 1), cB + hstepB, voffB); PG8_STAGE(PG8_SA(0, 0), cA, voffA); PG8_STAGE(PG8_SA(0, 1), cA + hstepA, voffA);
    if (wr == 1) PG8_BAR;
    PG8_WAIT_V(2); PG8_BAR;
    PG8_STAGE(PG8_SB(1, 0), cB + kstep, voffB); PG8_STAGE(PG8_SA(1, 0), cA + kstep, voffA); PG8_STAGE(PG8_SB(1, 1), cB + hstepB + kstep, voffB);
    PG8_WAIT_V(6); PG8_BAR;
    for (;;) {
        const bool has_next = S.next(ui + 1, nxt);
        const char* nA = has_next ? PG8_UA(nxt) : cA; const char* nB = has_next ? PG8_UB(nxt) : cB;
        for (int t = 0; t < nt; t += 2) {
            const bool last = (t == nt - 2);
            const char* a1 = cA + (size_t)(t + 1) * kstep;
            const char* a2 = last ? nA : cA + (size_t)(t + 2) * kstep; const char* b2 = last ? nB : cB + (size_t)(t + 2) * kstep;
            const char* a3 = a2 + kstep; const char* b3 = b2 + kstep;
            PG8_LDB(B0, 0, 0); PG8_LDB(B1, 0, 1); PG8_SCHED; PG8_LDA(At, 0, 0); PG8_STAGE(PG8_SA(1, 1), a1 + hstepA, voffA);
            PG8_WAIT_V(8); PG8_WAIT_L(0); PG8_BAR; PG8_MMA(0, 0, At, B0); PG8_MMA(0, 1, At, B1); PG8_BAR; PG8_SCHED;
            PG8_LDA(At, 0, 1); PG8_STAGE(PG8_SB(0, 0), b2, voffB); PG8_STAGE(PG8_SB(0, 1), b2 + hstepB, voffB); PG8_STAGE(PG8_SA(0, 0), a2, voffA);
            PG8_WAIT_V(8); PG8_WAIT_L(0); PG8_BAR; PG8_MMA(1, 0, At, B0); PG8_MMA(1, 1, At, B1); PG8_BAR; PG8_SCHED;
            PG8_LDB(B0, 1, 0); PG8_LDB(B1, 1, 1); PG8_SCHED; PG8_LDA(At, 1, 0); PG8_STAGE(PG8_SA(0, 1), a2 + hstepA, voffA);
            PG8_WAIT_V(8); PG8_WAIT_L(0); PG8_BAR; PG8_MMA(0, 0, At, B0); PG8_MMA(0, 1, At, B1); PG8_BAR; PG8_SCHED;
            PG8_LDA(At, 1, 1); PG8_STAGE(PG8_SB(1, 0), b3, voffB); PG8_STAGE(PG8_SB(1, 1), b3 + hstepB, voffB); PG8_STAGE(PG8_SA(1, 0), a3, voffA);
            PG8_WAIT_V(8); PG8_WAIT_L(0); PG8_BAR; PG8_MMA(1, 0, At, B0); PG8_MMA(1, 1, At, B1); PG8_BAR; PG8_SCHED;
        }
        if constexpr (ALIGN_EPI) { if (wr == 0) PG8_BAR; }
        if constexpr (!Epi::AFTER_DRAIN) E(acc, cur, wr, wc, fr, fq);
        if (!has_next) break;
#pragma unroll
        for (int a = 0; a < 2; ++a)
#pragma unroll
            for (int b = 0; b < 2; ++b)
#pragma unroll
                for (int m = 0; m < 4; ++m)
#pragma unroll
                    for (int n = 0; n < 2; ++n) acc[a][b][m][n] = (f32x4){0.f, 0.f, 0.f, 0.f};
        cur = nxt; cA = nA; cB = nB; ++ui;
        if constexpr (ALIGN_EPI) { if (wr == 1) PG8_BAR; }
    }
    PG8_WAIT_V(0);
    if constexpr (!ALIGN_EPI) { if (wr == 0) PG8_BAR; }
    PG8_BAR;
    if constexpr (Epi::AFTER_DRAIN) E(acc, cur, wr, wc, fr, fq);
#undef PG8_UA
#undef PG8_UB
#undef PG8_SA
#undef PG8_SB
#undef PG8_STAGE
#undef PG8_LDA
#undef PG8_LDB
#undef PG8_MMA
#undef PG8_WAIT_V
#undef PG8_WAIT_L
#undef PG8_BAR
#undef PG8_SCHED
}
}

__device__ __forceinline__ float wave_sum(float v) {
#pragma unroll
    for (int o = 1; o < 64; o <<= 1) v += __shfl_xor(v, o);
    return v;
}
__device__ __forceinline__ void transpose_item(const float* W, int K, int N, int Npad, int Nst, bf16_t* WT, const float* gk, LAS float* scr, int item, int lane, bool glu_map = false) {
    const int nblk = Npad / 128, kb = item / nblk, nb = item % nblk, k0 = 32 * kb, n0 = 128 * nb;
    const int nn = n0 + 4 * (lane & 31), kh = lane >> 5; const bool ok = nn < N;
    f32x4 v[16];
#pragma unroll
    for (int i = 0; i < 16; ++i) v[i] = ok ? __builtin_nontemporal_load((const f32x4*)(W + (size_t)(k0 + 2 * i + kh) * N + nn)) : (f32x4){0.f, 0.f, 0.f, 0.f};
    if (gk) {
#pragma unroll
        for (int i = 0; i < 16; ++i) v[i] *= gk[k0 + 2 * i + kh];
    }
#pragma unroll
    for (int i = 0; i < 16; ++i) *(LAS f32x4*)(scr + (2 * i + kh) * 132 + 4 * (lane & 31)) = v[i];
    asm volatile("s_waitcnt lgkmcnt(0)" ::: "memory");
    const int kq = lane & 3;
#pragma unroll
    for (int j = 0; j < 8; ++j) { const int n = (lane >> 2) + 16 * j; const LAS float* sp = scr + (8 * kq) * 132 + n;
        u32x4 o; o.x = cvt_pk_bf16(sp[0 * 132], sp[1 * 132]); o.y = cvt_pk_bf16(sp[2 * 132], sp[3 * 132]); o.z = cvt_pk_bf16(sp[4 * 132], sp[5 * 132]); o.w = cvt_pk_bf16(sp[6 * 132], sp[7 * 132]);
        const int nbo = glu_map ? (nb < 8 ? 2 * nb : (nb < 16 ? 2 * (nb - 8) + 1 : nb)) : nb;
        if (n0 + n < Nst) *(u32x4*)(WT + (size_t)(128 * nbo + n) * K + k0 + 8 * kq) = o; }
    asm volatile("s_waitcnt lgkmcnt(0)" ::: "memory");
}

struct Args { const float* in[20]; float* out; unsigned char* ws; int ph_lo, ph_hi; };

__device__ __forceinline__ void conv_tile(LAS unsigned char* lds, const bf16_t* PROJ, const float* conv_w, const float* conv_b, const float* ln_g, const float* ln_b, bf16_t* CO, int tile) {
    const int tid = threadIdx.x, lane = tid & 63, wid = tid >> 6, c0 = 2 * tid, t0 = tile * 16;
    f32x2 w[31];
#pragma unroll
    for (int k = 0; k < 31; ++k) w[k] = *(const f32x2*)(conv_w + k * 1024 + c0);
    const f32x2 bias = *(const f32x2*)(conv_b + c0);
    f32x2 u[46];
    const bf16_t* pp = PROJ + ((long)t0 - 30) * LDP + 256 * (c0 >> 7) + (c0 & 127);
#pragma unroll
    for (int sidx = 0; sidx < 46; ++sidx) { unsigned ru = 0u; if (t0 - 30 + sidx >= 0) ru = *(const unsigned*)(pp + (size_t)sidx * LDP); u[sidx] = (f32x2){bflo(ru), bfhi(ru)}; }
    f32x2 acc[16];
#pragma unroll
    for (int o = 0; o < 16; ++o) { f32x2 a = bias;
#pragma unroll
        for (int k = 0; k < 31; ++k) a += u[o + 30 - k] * w[30 - k];
        acc[o] = a; }
    LAS f32x2* part = (LAS f32x2*)lds;
    LAS float* red = (LAS float*)(lds + 65536);
#pragma unroll
    for (int o = 0; o < 16; ++o) part[o * 512 + tid] = (f32x2){acc[o].x + acc[o].y, acc[o].x * acc[o].x + acc[o].y * acc[o].y};
    __syncthreads();
    { const int o = tid >> 5, sg = tid & 31; f32x2 a = (f32x2){0.f, 0.f};
#pragma unroll
        for (int e = 0; e < 16; ++e) a += part[o * 512 + e * 32 + sg];
#pragma unroll
        for (int sh = 1; sh < 32; sh <<= 1) { a.x += __shfl_xor(a.x, sh); a.y += __shfl_xor(a.y, sh); }
        if (sg == 0) { red[o * 2] = a.x; red[o * 2 + 1] = a.y; } }
    __syncthreads();
    const f32x2 gg = *(const f32x2*)(ln_g + c0), bb = *(const f32x2*)(ln_b + c0);
#pragma unroll
    for (int o = 0; o < 16; ++o) { const float s1 = red[o * 2], s2 = red[o * 2 + 1];
        const float mean = s1 * (1.f / 1024.f), var = fmaxf(s2 * (1.f / 1024.f) - mean * mean, 0.f), rstd = __builtin_amdgcn_rsqf(var + EPS);
        float y0 = (acc[o].x - mean) * rstd * gg.x + bb.x, y1 = (acc[o].y - mean) * rstd * gg.y + bb.y;
        y0 = y0 * sigmoidf_(y0); y1 = y1 * sigmoidf_(y1);
        *(unsigned*)(CO + (size_t)(t0 + o) * DM + c0) = cvt_pk_bf16(y0, y1); }
    __syncthreads();
}

__device__ __forceinline__ void compress_unit(LAS unsigned char* lds, const bf16_t* PROJ, const float* pos, const bf16_t* w1t, const bf16_t* w2t, bf16_t* outp, int kv, int g, int ntile) {
    const int tid = threadIdx.x, lane = tid & 63, wid = __builtin_amdgcn_readfirstlane(tid >> 6), fr = lane & 15, fq = lane >> 4;
    const int n = ntile * 16 + fr; const bool ok = n < 511;
    const int coloff = (kv ? OFF_VC : OFF_KC) + g * 64;
    const bf16_t* arow = PROJ + (size_t)(16 * (ok ? n : 0)) * LDP + coloff + fq * 8;
    u32x4 av[8];
#pragma unroll
    for (int e = 0; e < 8; ++e) { const int kk = wid * 8 + e, l = kk >> 1, d = (kk & 1) * 32; av[e] = *(const u32x4*)(arow + (size_t)l * LDP + d); }
    bf16x8 ab[8];
#pragma unroll
    for (int e = 0; e < 8; ++e) { const int kk = wid * 8 + e, l = kk >> 1, d = (kk & 1) * 32; const u32x4 a = av[e];
        const f32x4 p0 = *(const f32x4*)(pos + l * 64 + d + fq * 8), p1 = *(const f32x4*)(pos + l * 64 + d + fq * 8 + 4);
        u32x4 t;
        t.x = cvt_pk_bf16(bflo(a.x) + p0[0], bfhi(a.x) + p0[1]); t.y = cvt_pk_bf16(bflo(a.y) + p0[2], bfhi(a.y) + p0[3]);
        t.z = cvt_pk_bf16(bflo(a.z) + p1[0], bfhi(a.z) + p1[1]); t.w = cvt_pk_bf16(bflo(a.w) + p1[2], bfhi(a.w) + p1[3]);
        if (!ok) t = (u32x4){0u, 0u, 0u, 0u};
        ab[e] = __builtin_bit_cast(bf16x8, t); }
    LAS float* psum = (LAS float*)lds;
    LAS bf16_t* hb = (LAS bf16_t*)(lds + 65536);
#pragma unroll
    for (int ct = 0; ct < 8; ++ct) {
        const bf16_t* brow = w1t + (size_t)(ct * 16 + fr) * 2048 + wid * 256 + fq * 8;
        bf16x8 bv[8];
#pragma unroll
        for (int e = 0; e < 8; ++e) bv[e] = *(const bf16x8*)(brow + e * 32);
        f32x4 acc = (f32x4){0.f, 0.f, 0.f, 0.f};
#pragma unroll
        for (int e = 0; e < 8; ++e) acc = __builtin_amdgcn_mfma_f32_16x16x32_bf16(ab[e], bv[e], acc, 0, 0, 0);
#pragma unroll
        for (int j = 0; j < 4; ++j) psum[wid * 2048 + (fq * 4 + j) * 128 + ct * 16 + fr] = acc[j];
    }
    __syncthreads();
    { f32x4 t = *(const LAS f32x4*)(psum + tid * 4);
#pragma unroll
        for (int v = 1; v < 8; ++v) t += *(const LAS f32x4*)(psum + v * 2048 + tid * 4);
        const int nr = tid >> 5, hc = (tid & 31) * 4;
        u32x2 o; o.x = cvt_pk_bf16(t[0] * sigmoidf_(t[0]), t[1] * sigmoidf_(t[1])); o.y = cvt_pk_bf16(t[2] * sigmoidf_(t[2]), t[3] * sigmoidf_(t[3]));
        *(LAS u32x2*)(hb + nr * 136 + hc) = o; }
    __syncthreads();
    if (wid < 4) {
        f32x4 o = (f32x4){0.f, 0.f, 0.f, 0.f};
#pragma unroll
        for (int kk = 0; kk < 4; ++kk) {
            const bf16x8 af = *(const LAS bf16x8*)(hb + fr * 136 + kk * 32 + fq * 8);
            const bf16x8 bf = *(const bf16x8*)(w2t + (size_t)(wid * 16 + fr) * 128 + kk * 32 + fq * 8);
            o = __builtin_amdgcn_mfma_f32_16x16x32_bf16(af, bf, o, 0, 0, 0);
        }
        const int col = wid * 16 + fr;
#pragma unroll
        for (int j = 0; j < 4; ++j) { const int nn = ntile * 16 + fq * 4 + j; const bf16_t v = (bf16_t)(cvt_pk_bf16(o[j], 0.f) & 0xffffu);
            outp[((size_t)g * 512 + nn) * 64 + col] = v; }
    }
    __syncthreads();
}

namespace att {
constexpr int SLOT = 16384, LDS_FIN = 65536, LDS_IMP = 65536  , IMPROW = 129, LDS_SEL = 131072, LDS_END = LDS_SEL + 1024;
constexpr float C2 = 0.125f * 1.4426950408889634f;
constexpr float NEG = -1e30f;

template <int MODE, bool FULL, int POS>
__device__ __forceinline__ void tile_body(LAS unsigned char* lds, LAS unsigned char* kb, int tile, const bf16x8 (&qf)[2][2], int t0, float (&m)[2], float (&l)[2], bool (&ini)[2], f32x4 (&oacc)[2][4], bf16x8 (&kfx)[4][2]) {
    int tid = threadIdx.x; asm volatile("" : "+v"(tid));
    const int lane = tid & 63, fr = lane & 15, fq = lane >> 4;
    LAS unsigned* impu = (LAS unsigned*)(lds + LDS_IMP); LAS unsigned* sel = (LAS unsigned*)(lds + LDS_SEL);
    const int swz = (fr >> 1) & 7;
    const int key0 = tile * 64;
    const int tlb = ((tid >> 6) & 1) * 32 + fr;
    constexpr float THR = 8.0f, NINF = -INFINITY;
    float ci[2];
#pragma unroll
    for (int qs = 0; qs < 2; ++qs) {
        if (MODE == 1) ci[qs] = m[qs]; else ci[qs] = ini[qs] ? -m[qs] : 0.f;
        if (MODE == 2) { const bool selb = ((sel[(tlb + qs * 16) * 4 + (tile >> 5)] >> (tile & 31)) & 1u) != 0u; if (!selb) ci[qs] = NINF; }
    }
    f32x4 sacc[2][4];
#pragma unroll
    for (int ks = 0; ks < 4; ++ks) {
        bf16x8 k0, k1;
        if (POS == 0) { k0 = *(const LAS bf16x8*)(kb + (ks * 16 + fr) * 128 + ((fq ^ swz) * 16)); k1 = *(const LAS bf16x8*)(kb + (ks * 16 + fr) * 128 + (((4 + fq) ^ swz) * 16)); }
        else { k0 = kfx[ks][0]; k1 = kfx[ks][1]; }
#pragma unroll
        for (int qs = 0; qs < 2; ++qs) { f32x4 z = (f32x4){ci[qs], ci[qs], ci[qs], ci[qs]};
            z = __builtin_amdgcn_mfma_f32_16x16x32_bf16(k0, qf[qs][0], z, 0, 0, 0); sacc[qs][ks] = __builtin_amdgcn_mfma_f32_16x16x32_bf16(k1, qf[qs][1], z, 0, 0, 0); }
    }
    bf16x8 pf[2][2];
#pragma unroll
    for (int qs = 0; qs < 2; ++qs) {
        if constexpr (!FULL) {
            const int t = t0 + tlb + qs * 16;
#pragma unroll
            for (int ks = 0; ks < 4; ++ks)
#pragma unroll
                for (int j = 0; j < 4; ++j) { const int key = key0 + ks * 16 + fq * 4 + j; bool valid;
                    if (MODE <= 1) valid = (16 * key + 31 <= t); else if (MODE == 2) valid = (key <= t); else valid = (key <= t) && (key > t - 512);
                    if (!valid) sacc[qs][ks][j] = NINF; }
        }
        if (MODE == 1) {
            const int tl = tlb + qs * 16;
#pragma unroll
            for (int ks = 0; ks < 4; ++ks) { float p[4];
#pragma unroll
                for (int j = 0; j < 4; ++j) { p[j] = fexp2(sacc[qs][ks][j]); sacc[qs][ks][j] = p[j]; }
                const int j0 = (key0 + ks * 16 + fq * 4) >> 2;
                const float s4 = (p[0] + p[1]) + (p[2] + p[3]);
                if (FULL || s4 > 0.f) { __hip_atomic_fetch_add(&impu[tl * IMPROW + j0], (unsigned)(s4 * 134217728.0f + 0.5f), __ATOMIC_RELAXED, __HIP_MEMORY_SCOPE_WORKGROUP);
                    if (j0 + 1 < 128) __hip_atomic_fetch_add(&impu[tl * IMPROW + j0 + 1], (unsigned)(p[3] * 134217728.0f + 0.5f), __ATOMIC_RELAXED, __HIP_MEMORY_SCOPE_WORKGROUP); } }
        } else {
            float mt = fmaxf(fmaxf(sacc[qs][0][0], sacc[qs][0][1]), fmaxf(sacc[qs][0][2], sacc[qs][0][3]));
#pragma unroll
            for (int ks = 1; ks < 4; ++ks) mt = fmaxf(mt, fmaxf(fmaxf(sacc[qs][ks][0], sacc[qs][ks][1]), fmaxf(sacc[qs][ks][2], sacc[qs][ks][3])));
            const bool trig = (mt > THR) || (!ini[qs] && mt > NINF);
            if (__any(trig)) {
                float rm = mt;
                if (MODE >= 2) { rm = fmaxf(rm, __shfl_xor(rm, 16)); rm = fmaxf(rm, __shfl_xor(rm, 32)); }
                float delta = 0.f;
                if (!ini[qs]) { if (rm > NINF) { delta = rm; ini[qs] = true; m[qs] = rm; } }
                else { delta = fmaxf(rm, 0.f); m[qs] += delta; const float alpha = fexp2(-delta); l[qs] *= alpha;
                    if (MODE >= 2) {
#pragma unroll
                        for (int ds = 0; ds < 4; ++ds) oacc[qs][ds] *= alpha; } }
#pragma unroll
                for (int ks = 0; ks < 4; ++ks) sacc[qs][ks] -= delta;
            }
            float ps = 0.f;
#pragma unroll
            for (int ks = 0; ks < 4; ++ks)
#pragma unroll
                for (int j = 0; j < 4; ++j) { const float p = fexp2(sacc[qs][ks][j]); sacc[qs][ks][j] = p; ps += p; }
            l[qs] += ps;
        }
        if (MODE != 0) {
#pragma unroll
            for (int kc = 0; kc < 2; ++kc) { u32x4 w; const f32x4 a = sacc[qs][2 * kc], b = sacc[qs][2 * kc + 1];
                w.x = cvt_pk_bf16(a[0], a[1]); w.y = cvt_pk_bf16(a[2], a[3]); w.z = cvt_pk_bf16(b[0], b[1]); w.w = cvt_pk_bf16(b[2], b[3]); pf[qs][kc] = __builtin_bit_cast(bf16x8, w); }
        }
    }
    if (POS == 0) {
#pragma unroll
        for (int ks = 0; ks < 4; ++ks) { kfx[ks][0] = *(const LAS bf16x8*)(kb + SLOT + (ks * 16 + fr) * 128 + ((fq ^ swz) * 16)); kfx[ks][1] = *(const LAS bf16x8*)(kb + SLOT + (ks * 16 + fr) * 128 + (((4 + fq) ^ swz) * 16)); }
    }
    if (MODE != 0) {
#pragma unroll
        for (int ds = 0; ds < 4; ++ds)
#pragma unroll
            for (int kc = 0; kc < 2; ++kc) {
                const int vr0 = 32 * kc + 4 * fq + (fr >> 2), vr1 = vr0 + 16, vch = 2 * ds + ((fr & 3) >> 1);
                const v4i16_t t0 = __builtin_amdgcn_ds_read_tr16_b64_v4i16((LAS v4i16_t*)(kb + 8192 + vr0 * 128 + ((vch ^ ((vr0 >> 1) & 7)) * 16) + (fr & 1) * 8));
                const v4i16_t t1 = __builtin_amdgcn_ds_read_tr16_b64_v4i16((LAS v4i16_t*)(kb + 8192 + vr1 * 128 + ((vch ^ ((vr1 >> 1) & 7)) * 16) + (fr & 1) * 8));
                const bf16x8 vf = (bf16x8){t0[0], t0[1], t0[2], t0[3], t1[0], t1[1], t1[2], t1[3]};
#pragma unroll
                for (int qs = 0; qs < 2; ++qs) oacc[qs][ds] = __builtin_amdgcn_mfma_f32_16x16x32_bf16(vf, pf[qs][kc], oacc[qs][ds], 0, 0, 0);
            }
    }
}

template <int MODE>
__device__ __forceinline__ void branch(LAS unsigned char* lds, const bf16_t* kbase, int kstride, const bf16_t* vbase, int vstride, int tlo, int thi,
                                       const bf16x8 (&qf)[2][2], int itile, float (&m)[2], float (&l)[2], bool (&ini)[2], f32x4 (&oacc)[2][4],
                                       int& slot_io, bool preloaded, bool has_next, const bf16_t* nkbase, int nkstride, const bf16_t* nvbase, int nvstride, int ntlo, int nthi) {
    const int wid = __builtin_amdgcn_readfirstlane((int)threadIdx.x >> 6);
#define ATT_OFFS(ks_, vs_) int tid_ = threadIdx.x; asm volatile("" : "+v"(tid_)); const int lane_ = tid_ & 63, lr = (tid_ >> 6) * 8 + (lane_ >> 3), lc = (lane_ & 7) ^ ((lr >> 1) & 7); \
        const unsigned koff = (unsigned)(lr * (ks_) + lc * 8) * 2u, voff = (unsigned)(lr * (vs_) + lc * 8) * 2u; const unsigned nkoff = koff, nvoff = voff; (void)nkoff; (void)nvoff
#define ATT_DMA(t, slot) do { __builtin_amdgcn_global_load_lds((const unsigned*)((const char*)kbase + (size_t)(t) * 128 * kstride + koff), (LAS unsigned*)(lds + (slot) * SLOT + wid * 1024), 16, 0, 0); \
        __builtin_amdgcn_global_load_lds((const unsigned*)((const char*)vbase + (size_t)(t) * 128 * vstride + voff), (LAS unsigned*)(lds + (slot) * SLOT + 8192 + wid * 1024), 16, 0, 0); } while (0)
#define ATT_NDMA(t, slot) do { __builtin_amdgcn_global_load_lds((const unsigned*)((const char*)nkbase + (size_t)(t) * 128 * nkstride + nkoff), (LAS unsigned*)(lds + (slot) * SLOT + wid * 1024), 16, 0, 0); \
        __builtin_amdgcn_global_load_lds((const unsigned*)((const char*)nvbase + (size_t)(t) * 128 * nvstride + nvoff), (LAS unsigned*)(lds + (slot) * SLOT + 8192 + wid * 1024), 16, 0, 0); } while (0)
    int slot = slot_io;
    if (!preloaded) { __builtin_amdgcn_s_barrier();
        ATT_OFFS(kstride, vstride); slot = 0; ATT_DMA(tlo, 0); if (tlo + 1 <= thi) ATT_DMA(tlo + 1, 1); }
    for (int tile = tlo; tile <= thi; tile += 2) {
        asm volatile("s_waitcnt vmcnt(0)" ::: "memory"); __builtin_amdgcn_s_barrier(); asm volatile("" ::: "memory");
        if (tile + 2 <= thi) { ATT_OFFS(kstride, vstride); ATT_DMA(tile + 2, slot ^ 2); if (tile + 3 <= thi) ATT_DMA(tile + 3, (slot ^ 2) + 1); }
        else if (has_next) { ATT_OFFS(nkstride, nvstride); ATT_NDMA(ntlo, slot ^ 2); if (ntlo + 1 <= nthi) ATT_NDMA(ntlo + 1, (slot ^ 2) + 1); }
        bf16x8 kfx[4][2];
        { const int tt = tile; bool full;
          if (MODE <= 1) full = (1024 * tt + 1039 <= 64 * itile); else if (MODE == 2) full = tt < itile; else full = (tt < itile) && (tt > itile - 8);
          if (full) tile_body<MODE, true, 0>(lds, lds + slot * SLOT, tt, qf, itile * 64, m, l, ini, oacc, kfx);
          else tile_body<MODE, false, 0>(lds, lds + slot * SLOT, tt, qf, itile * 64, m, l, ini, oacc, kfx); }
        if (tile + 1 <= thi) { const int tt = tile + 1; bool full;
          if (MODE <= 1) full = (1024 * tt + 1039 <= 64 * itile); else if (MODE == 2) full = tt < itile; else full = (tt < itile) && (tt > itile - 8);
          if (full) tile_body<MODE, true, 1>(lds, lds + (slot + 1) * SLOT, tt, qf, itile * 64, m, l, ini, oacc, kfx);
          else tile_body<MODE, false, 1>(lds, lds + (slot + 1) * SLOT, tt, qf, itile * 64, m, l, ini, oacc, kfx); }
        slot ^= 2;
    }
    slot_io = slot;
    asm volatile("s_waitcnt lgkmcnt(0)" ::: "memory"); __builtin_amdgcn_s_barrier(); asm volatile("" ::: "memory");
#undef ATT_DMA
#undef ATT_NDMA
#undef ATT_OFFS
}

__device__ __forceinline__ void unit(LAS unsigned char* lds, const bf16_t* PROJ, const bf16_t* KC, const bf16_t* VCT, const bf16_t* VTS, const bf16_t* VTW, bf16_t* CO, int i, int g) {
    const int tid = threadIdx.x, lane = tid & 63, wid = __builtin_amdgcn_readfirstlane(tid >> 6), fr = lane & 15, fq = lane >> 4;
    const int r = wid >> 1, th = wid & 1, h = g * 4 + r, t0 = i * 64, tlb = th * 32 + fr;
    LAS unsigned* impu = (LAS unsigned*)(lds + LDS_IMP); LAS unsigned* sel = (LAS unsigned*)(lds + LDS_SEL);
    int tq[2]; bf16x8 qf[2][2];
#define ATT_GATE(qs, b) sigmoidf_(bf2f(PROJ[(size_t)tq[qs] * LDP + OFF_GL + h * 3 + (b)]))
#pragma unroll
    for (int qs = 0; qs < 2; ++qs) { tq[qs] = t0 + th * 32 + qs * 16 + fr;
#pragma unroll
        for (int dc = 0; dc < 2; ++dc) { const u32x4 qr = *(const u32x4*)(PROJ + (size_t)tq[qs] * LDP + OFF_Q + h * 64 + dc * 32 + fq * 8); u32x4 qw;
            qw.x = cvt_pk_bf16(bflo(qr.x) * C2, bfhi(qr.x) * C2); qw.y = cvt_pk_bf16(bflo(qr.y) * C2, bfhi(qr.y) * C2); qw.z = cvt_pk_bf16(bflo(qr.z) * C2, bfhi(qr.z) * C2); qw.w = cvt_pk_bf16(bflo(qr.w) * C2, bfhi(qr.w) * C2);
            qf[qs][dc] = __builtin_bit_cast(bf16x8, qw); }
}
    for (int idx = tid; idx < 64 * IMPROW; idx += 512) impu[idx] = 0u;
    if (tid < 256) sel[tid] = 0u;
    f32x4 oacc[2][4];
    LAS f32x4* finl = (LAS f32x4*)(lds + LDS_FIN) + tid;
#pragma unroll
    for (int qs = 0; qs < 2; ++qs)
#pragma unroll
        for (int ds = 0; ds < 4; ++ds) oacc[qs][ds] = (f32x4){0.f, 0.f, 0.f, 0.f};
    __syncthreads();
    const int nct = (4 * i + 2) / 64;
    const bf16_t* kcb = KC + (size_t)g * 512 * 64; const bf16_t* vcb = VCT + (size_t)g * 512 * 64;
    float m[2] = {0.f, 0.f}, l[2] = {0.f, 0.f}; bool ini[2] = {false, false};
    const bf16_t* ksb = PROJ + OFF_KS + g * 64; const bf16_t* vsb = PROJ + OFF_VS + g * 64; const bf16_t* kwb = PROJ + OFF_KW + g * 64; const bf16_t* vwb = PROJ + OFF_VW + g * 64;
    const int wlo = (i >= 8 ? i - 8 : 0); int rslot = 0;
    branch<0>(lds, kcb, 64, vcb, 64, 0, nct, qf, i, m, l, ini, oacc, rslot, false, true, kcb, 64, vcb, 64, 0, nct);
#pragma unroll
    for (int qs = 0; qs < 2; ++qs) { const float ml = ini[qs] ? m[qs] : -INFINITY; float M = fmaxf(ml, __shfl_xor(ml, 16)); M = fmaxf(M, __shfl_xor(M, 32));
        float la = ini[qs] ? l[qs] * fexp2(m[qs] - M) : 0.f; la += __shfl_xor(la, 16); la += __shfl_xor(la, 32);
        m[qs] = la > 0.f ? -M - __builtin_amdgcn_logf(la) : -INFINITY; l[qs] = 0.f; ini[qs] = true; }
    branch<1>(lds, kcb, 64, vcb, 64, 0, nct, qf, i, m, l, ini, oacc, rslot, true, true, ksb, LDP, vsb, LDP, 0, i);
    {
        const int tl = tid >> 3, jg = tid & 7;
        unsigned key[16];
#pragma unroll
        for (int jj = 0; jj < 16; ++jj) { const int j = jg * 16 + jj; const unsigned v = impu[tl * IMPROW + j]; const bool el = (j >= 1) && (j <= i - 2); key[jj] = el ? ((v & ~127u) | (unsigned)(127 - j)) : 0u; }
        unsigned T = 0u;
        for (int bit = 31; bit >= 0; --bit) { const unsigned cand = T | (1u << bit); int c = 0;
#pragma unroll
            for (int jj = 0; jj < 16; ++jj) c += (key[jj] >= cand) ? 1 : 0;
            c += __shfl_xor(c, 1); c += __shfl_xor(c, 2); c += __shfl_xor(c, 4);
            if (c >= 13) T = cand; }
        unsigned bits = 0u;
#pragma unroll
        for (int jj = 0; jj < 16; ++jj) { const int j = jg * 16 + jj; const bool el = (j >= 1) && (j <= i - 2);
            const bool f = (j == 0) || (j == i) || (j == i - 1) || (el && key[jj] >= T); if (f) bits |= (1u << jj); }
        __hip_atomic_fetch_or(&sel[tl * 4 + (jg >> 1)], bits << ((jg & 1) * 16), __ATOMIC_RELAXED, __HIP_MEMORY_SCOPE_WORKGROUP);
    }
    __syncthreads();
#pragma unroll
    for (int qs = 0; qs < 2; ++qs) { const float g0 = ATT_GATE(qs, 0);
#pragma unroll
        for (int ds = 0; ds < 4; ++ds) { finl[(qs * 4 + ds) * 512] = oacc[qs][ds] * g0; oacc[qs][ds] = (f32x4){0.f, 0.f, 0.f, 0.f}; } }
    m[0] = 0.f; m[1] = 0.f; l[0] = 0.f; l[1] = 0.f; ini[0] = false; ini[1] = false;
    branch<2>(lds, ksb, LDP, vsb, LDP, 0, i, qf, i, m, l, ini, oacc, rslot, true, true, kwb, LDP, vwb, LDP, wlo, i);
#pragma unroll
    for (int qs = 0; qs < 2; ++qs) { float la = l[qs]; la += __shfl_xor(la, 16); la += __shfl_xor(la, 32); const float sc = ATT_GATE(qs, 1) / la;
#pragma unroll
        for (int ds = 0; ds < 4; ++ds) { finl[(qs * 4 + ds) * 512] += oacc[qs][ds] * sc; oacc[qs][ds] = (f32x4){0.f, 0.f, 0.f, 0.f}; } }
    m[0] = 0.f; m[1] = 0.f; l[0] = 0.f; l[1] = 0.f; ini[0] = false; ini[1] = false;
    branch<3>(lds, kwb, LDP, vwb, LDP, wlo, i, qf, i, m, l, ini, oacc, rslot, true, false, kwb, LDP, vwb, LDP, wlo, i);
#pragma unroll
    for (int qs = 0; qs < 2; ++qs) { float la = l[qs]; la += __shfl_xor(la, 16); la += __shfl_xor(la, 32); const float sc = ATT_GATE(qs, 2) / la;
#pragma unroll
        for (int ds = 0; ds < 4; ++ds) oacc[qs][ds] = finl[(qs * 4 + ds) * 512] + oacc[qs][ds] * sc; }
#pragma unroll
    for (int qs = 0; qs < 2; ++qs)
#pragma unroll
        for (int ds = 0; ds < 4; ++ds) { u32x2 w; w.x = cvt_pk_bf16(oacc[qs][ds][0], oacc[qs][ds][1]); w.y = cvt_pk_bf16(oacc[qs][ds][2], oacc[qs][ds][3]);
            *(u32x2*)(CO + (size_t)tq[qs] * DM + 1024 + h * 64 + ds * 16 + fq * 4) = w; }
    __syncthreads();
}
}


#define XB_TMO      128
#define XB_XCNT(j)  (256  + 64 * (j))
#define XB_XSUB(j)  (1280 + 64 * (j))
#define XB_XGEN(j)  (2304 + 64 * (j))
#define XB_TOP      3328
#define XB_TOPGEN   3392
#define XCD_BAR_WORDS 3456
#define XB_SPIN_CAP (1u << 18)
__device__ __forceinline__ unsigned xb_ld(unsigned* p)              { return __hip_atomic_load(p, __ATOMIC_RELAXED, __HIP_MEMORY_SCOPE_AGENT); }
__device__ __forceinline__ unsigned xb_add(unsigned* p, unsigned v) { return __hip_atomic_fetch_add(p, v, __ATOMIC_RELAXED, __HIP_MEMORY_SCOPE_AGENT); }
__device__ __forceinline__ unsigned xb_xcc_id() { return (unsigned)__builtin_amdgcn_s_getreg((3 << 11) | 20) & 0xFu; }
#define XB_SPIN(cond, bar) do { unsigned _sp = 0; while (cond) { __builtin_amdgcn_s_sleep(1); \
    if ((++_sp & 255u) == 0u) { if (xb_ld(&(bar)[XB_TMO])) break; if (_sp > XB_SPIN_CAP) { atomicAdd(&(bar)[XB_TMO], 1u); break; } } } } while (0)
struct XcdBarrier { unsigned* bar; unsigned x; volatile LAS unsigned* st; };
__device__ __forceinline__ XcdBarrier xcd_barrier_post(unsigned* bar, volatile LAS unsigned* st) {
    XcdBarrier b; b.bar = bar; b.x = xb_xcc_id(); b.st = st;
    if (threadIdx.x == 0) (void)xb_add(&bar[XB_XCNT(b.x)], 1u);
    return b;
}
__device__ __forceinline__ void xcd_barrier_complete(unsigned* bar, unsigned x, unsigned& nloc, unsigned& nx) {
    const unsigned G = gridDim.x * gridDim.y * gridDim.z;
    unsigned sum, cnt, mine, sp = 0u;
    for (;;) {
        sum = 0u; cnt = 0u; mine = 0u;
#pragma unroll
        for (unsigned j = 0; j < 16; ++j) { const unsigned c = xb_ld(&bar[XB_XCNT(j)]); sum += c; cnt += (c > 0u) ? 1u : 0u; mine = (j == x) ? c : mine; }
        if (sum == G) break;
        __builtin_amdgcn_s_sleep(1);
        if ((++sp & 255u) == 0u) { if (xb_ld(&bar[XB_TMO])) break; if (sp > XB_SPIN_CAP) { atomicAdd(&bar[XB_TMO], 1u); break; } }
    }
    nloc = mine > 0u ? mine : 1u; nx = cnt > 0u ? cnt : 1u;
}
__device__ __forceinline__ void xcd_barrier(const XcdBarrier& b) {
    asm volatile("s_waitcnt vmcnt(0)" ::: "memory");
    __syncthreads();
    if (threadIdx.x == 0) {
        unsigned* bar = b.bar;
        __builtin_amdgcn_s_waitcnt(0);
        unsigned nloc = b.st[0], nx = b.st[1];
        if (nloc == 0u) { xcd_barrier_complete(bar, b.x, nloc, nx); b.st[0] = nloc; b.st[1] = nx; }
        const unsigned old = xb_add(&bar[XB_XSUB(b.x)], 1u);
        const unsigned gen = old / nloc;
        if (old + 1u == (gen + 1u) * nloc) {
            __builtin_amdgcn_fence(__ATOMIC_RELEASE, "agent");
            asm volatile("s_waitcnt vmcnt(0)" ::: "memory");
            const unsigned og = xb_add(&bar[XB_TOP], 1u);
            const unsigned tg = og / nx;
            if (og + 1u == (tg + 1u) * nx) xb_add(&bar[XB_TOPGEN], 1u);
            else XB_SPIN(xb_ld(&bar[XB_TOPGEN]) == tg, bar);
            __builtin_amdgcn_fence(__ATOMIC_ACQUIRE, "agent");
            xb_add(&bar[XB_XGEN(b.x)], 1u);
            asm volatile("s_waitcnt vmcnt(0)" ::: "memory");
        } else {
            XB_SPIN(xb_ld(&bar[XB_XGEN(b.x)]) == gen, bar);
            __builtin_amdgcn_fence(__ATOMIC_ACQUIRE, "agent");
            asm volatile("s_waitcnt vmcnt(0)" ::: "memory");
        }
    }
    __syncthreads();
}

constexpr int LDS_BYTES = 139264;

__global__ void __launch_bounds__(512) mega_fwd(Args args) {
    extern __shared__ __attribute__((aligned(16))) unsigned char lds_raw[];
    LAS unsigned char* lds = (LAS unsigned char*)lds_raw;
    cg::grid_group grid = cg::this_grid();
    const int tid = threadIdx.x, lane = tid & 63, wave = __builtin_amdgcn_readfirstlane(tid >> 6);
    const int G = gridDim.x, bx = blockIdx.x;
    unsigned char* ws = args.ws;
    const float* x = args.in[0]; const float* mix_norm = args.in[1]; const float* mlp_norm = args.in[2];
    float* out = args.out;
    float* ssq = (float*)(ws + WS_SSQ);
    bf16_t* PROJ = (bf16_t*)(ws + WS_PROJ); bf16_t* XB = (bf16_t*)(ws + WS_XB); bf16_t* CO = (bf16_t*)(ws + WS_CO); bf16_t* HB = (bf16_t*)(ws + WS_H);
    bf16_t* WIN = (bf16_t*)(ws + WS_WIN); bf16_t* WOUT = (bf16_t*)(ws + WS_WOUT); bf16_t* W1 = (bf16_t*)(ws + WS_W1); bf16_t* W2 = (bf16_t*)(ws + WS_W2); bf16_t* POOLT = (bf16_t*)(ws + WS_POOLT);
    bf16_t* KC = (bf16_t*)(ws + WS_KC); bf16_t* VCT = (bf16_t*)(ws + WS_VCT); bf16_t* VTS = (bf16_t*)(ws + WS_VTS); bf16_t* VTW = (bf16_t*)(ws + WS_VTW);
    const int lo = args.ph_lo, hi = args.ph_hi;
#ifndef ONLY_PHASE
#define ONLY_PHASE -1
#endif
#define IN(k) ((ONLY_PHASE < 0 || ONLY_PHASE == (k)) && lo <= (k) && (k) < hi)
    volatile LAS unsigned* misc = (volatile LAS unsigned*)(lds + 135168);
    if (tid < 2) misc[tid] = 0u;
    __syncthreads();
    XcdBarrier xbar = xcd_barrier_post((unsigned*)(ws + WS_BAR), misc);
#define SEAM(k) do { if (IN(k) && IN((k) + 1)) { if (hi == 99 + (k)) grid.sync(); else xcd_barrier(xbar); } } while (0)

    if (IN(0)) {
        LAS float* scr = (LAS float*)(lds + wave * 16896);
        const int gw = bx * 8 + wave, NGW = G * 8;
        for (int idx = bx * 512 + tid; idx < 4 * SEQ; idx += G * 512) ssq[idx] = 0.f;
        constexpr int I_W1 = (DM / 32) * (DFF / 128), I_W2 = (DFF / 32) * (DM / 128), I_IN = (DM / 32) * (LDP / 128), I_OUT = (DM / 32) * (DM / 128), I_POOL = (512 / 32) * (512 / 128),
                      I_C1 = (2048 / 32) * 1, I_C2 = (128 / 32) * 1;
        constexpr int NITEMS = 2 * I_W1 + I_IN + I_OUT + 4 * I_POOL + 2 * I_C1 + 2 * I_C2;
        for (int it = gw; it < NITEMS; it += NGW) {
            int r = it;
            if (r < 2 * I_W1) { const int ly = r / I_W1; transpose_item(args.in[3] + (size_t)ly * DM * DFF, DM, DFF, DFF, DFF, W1 + (size_t)ly * DM * DFF, mlp_norm + ly * DM, scr, r % I_W1, lane); continue; } r -= 2 * I_W1;
            if (r < I_IN) { transpose_item(args.in[5], DM, INC, LDP, LDP, WIN, mix_norm, scr, r, lane, true); continue; } r -= I_IN;
            if (r < I_OUT) { transpose_item(args.in[6], DM, DM, DM, DM, WOUT, nullptr, scr, r, lane); continue; } r -= I_OUT;
            if (r < 4 * I_POOL) { const int gi = r / I_POOL; transpose_item(args.in[17] + (size_t)gi * 512 * 512, 512, 512, 512, 512, POOLT + (size_t)gi * 512 * 512, mix_norm + DM + gi * 512, scr, r % I_POOL, lane); continue; } r -= 4 * I_POOL;
            if (r < 2 * I_C1) { const int kv = r / I_C1; transpose_item(args.in[kv ? 15 : 13], 2048, 128, 128, 128, (bf16_t*)(ws + (kv ? WS_CW1V : WS_CW1K)), nullptr, scr, r % I_C1, lane); continue; } r -= 2 * I_C1;
            { const int kv = r / I_C2; transpose_item(args.in[kv ? 16 : 14], 128, 64, 128, 64, (bf16_t*)(ws + (kv ? WS_CW2V : WS_CW2K)), nullptr, scr, r % I_C2, lane); }
        }
        for (int mrow = gw; mrow < SEQ; mrow += NGW) {
            const f32x4* xr = (const f32x4*)(x + (size_t)mrow * DM) + lane; f32x4 v[8]; float s = 0.f;
#pragma unroll
            for (int j = 0; j < 8; ++j) { v[j] = __builtin_nontemporal_load(xr + 64 * j); s += (v[j][0] * v[j][0] + v[j][1] * v[j][1]) + (v[j][2] * v[j][2] + v[j][3] * v[j][3]); }
            const float st = wave_sum(s); if (lane == 0) ssq[4 * SEQ + mrow] = st;
            u32x2* o8 = (u32x2*)(XB + (size_t)mrow * DM) + lane;
#pragma unroll
            for (int j = 0; j < 8; ++j) { u32x2 w; w.x = cvt_pk_bf16(v[j][0], v[j][1]); w.y = cvt_pk_bf16(v[j][2], v[j][3]); o8[64 * j] = w; }
        }
        __syncthreads();
    }
    SEAM(0);
    if (IN(1)) {
        pg8::Gemm g{XB, WIN, DM, DM, DM, 0, 0}; pg8::StaticOrder S; S.init(SEQ, LDP, G, bx);
        pg8::EpiBf16 E{PROJ, LDP, 8, ssq + 4 * SEQ};
        pg8::gemm_phase<pg8::EpiBf16, pg8::StaticOrder, true>(lds, g, S, E);
        constexpr int NW3 = (SEQ / 256) * (LDP / 256) - 2 * 256;
        const int first = (G == 256) ? NW3 : 0, nidle = G - first;
        if (bx >= first) {
            LAS float* scr = (LAS float*)(lds + wave * 16896);
            constexpr int I_W2 = (DFF / 32) * (DM / 128);
            for (int it = (bx - first) * 8 + wave; it < 2 * I_W2; it += nidle * 8) { const int ly = it / I_W2;
                transpose_item(args.in[4] + (size_t)ly * DM * DFF, DFF, DM, DM, DM, W2 + (size_t)ly * DM * DFF, nullptr, scr, it % I_W2, lane); }
            __syncthreads();
        }
    }
    SEAM(1);
    if (IN(2)) {
        for (int u = bx; u < 512; u += G) conv_tile(lds, PROJ, args.in[7], args.in[8], args.in[9], args.in[10], CO, u);
        for (int u = bx; u < 256; u += G) { const int kv = u >> 7, g = (u >> 5) & 3, nt = u & 31;
            compress_unit(lds, PROJ, args.in[kv ? 12 : 11], (const bf16_t*)(ws + (kv ? WS_CW1V : WS_CW1K)), (const bf16_t*)(ws + (kv ? WS_CW2V : WS_CW2K)), kv ? VCT : KC, kv, g, nt); }
    }
    SEAM(2);
    if (IN(3)) {
        for (int u = bx; u < 256; u += G) { const int g = (u & 7) >> 1, pb = ((u >> 3) << 1) | (u & 1);
            att::unit(lds, PROJ, KC, VCT, VTS, VTW, CO, 127 - pb, g);
            att::unit(lds, PROJ, KC, VCT, VTS, VTW, CO, pb, g); }
    }
    SEAM(3);
    if (IN(4)) {
        pg8::Gemm g{CO, WOUT, DM, DM, DM, 0, 0}; pg8::StaticOrder S; S.init(SEQ, DM, G, bx);
        pg8::EpiResB<bf16_t> E{XB, XB, nullptr, ssq, nullptr, DM};
        pg8::gemm_phase<pg8::EpiResB<bf16_t>, pg8::StaticOrder, false>(lds, g, S, E);
    }
    SEAM(4);
    if (IN(5)) {
        pg8::Gemm g{XB, W1, DM, DM, DM, 0, 0}; pg8::StaticOrder S; S.init(SEQ, DFF, G, bx);
        pg8::EpiRelu2 E{HB, DFF, ssq};
        pg8::gemm_phase<pg8::EpiRelu2, pg8::StaticOrder, true>(lds, g, S, E);
    }
    SEAM(5);
    if (IN(6)) {
        pg8::Gemm g{HB, W2, DFF, DFF, DFF, 0, 0}; pg8::StaticOrder S; S.init(SEQ, DM, G, bx);
        pg8::EpiResB<bf16_t> E{XB, XB, nullptr, ssq + SEQ, nullptr, DM};
        pg8::gemm_phase<pg8::EpiResB<bf16_t>, pg8::StaticOrder, false>(lds, g, S, E);
    }
    SEAM(6);
    if (IN(8)) {
        pg8::Gemm g{XB, POOLT, DM, 512, 512, 1, 1024}; pg8::StaticOrder S; S.init(SEQ, DM, G, bx);
        if (G == 256) { pg8::EpiPool E{XB, ssq + SEQ, ssq + 2 * SEQ, args.in[18], (unsigned long long*)(ws + WS_CO), (unsigned*)(ws + WS_BAR + 24576), DM, lds};
            pg8::gemm_phase<pg8::EpiPool, pg8::StaticOrder, false>(lds, g, S, E); }
    }
    SEAM(8);
    if (IN(9)) {
        pg8::Gemm g{XB, W1 + (size_t)DM * DFF, DM, DM, DM, 0, 0}; pg8::StaticOrder S; S.init(SEQ, DFF, G, bx);
        pg8::EpiRelu2 E{HB, DFF, ssq + 2 * SEQ};
        pg8::gemm_phase<pg8::EpiRelu2, pg8::StaticOrder, true>(lds, g, S, E);
    }
    SEAM(9);
    if (IN(10)) {
        pg8::Gemm g{HB, W2 + (size_t)DM * DFF, DFF, DFF, DFF, 0, 0}; pg8::StaticOrder S; S.init(SEQ, DM, G, bx);
        if (G == 256) { pg8::EpiFinal E{XB, out, ssq + 3 * SEQ, (unsigned*)(ws + WS_BAR + 16384), args.in[19], DM};
            pg8::gemm_phase<pg8::EpiFinal, pg8::StaticOrder, false>(lds, g, S, E); }
        else { pg8::EpiResB<bf16_t> E{XB, nullptr, out, ssq + 3 * SEQ, nullptr, DM};
            pg8::gemm_phase<pg8::EpiResB<bf16_t>, pg8::StaticOrder, false>(lds, g, S, E); }
    }
    if (G != 256) SEAM(10);
    if (IN(11) && G != 256) {
        const float* ss = ssq + 3 * SEQ; const float* fg = args.in[19];
        const int c = tid * 4; const f32x4 gg = *(const f32x4*)(fg + c);
        for (int t0 = bx * 8; t0 < SEQ; t0 += G * 8) {
            f32x4 v[8]; float rr[8];
#pragma unroll
            for (int j = 0; j < 8; ++j) { v[j] = *(const f32x4*)(out + (size_t)(t0 + j) * DM + c); rr[j] = ss[t0 + j]; }
#pragma unroll
            for (int j = 0; j < 8; ++j) *(f32x4*)(out + (size_t)(t0 + j) * DM + c) = v[j] * __builtin_amdgcn_rsqf(rr[j] * (1.f / DM) + EPS) * gg;
        }
    }
    if (IN(12)) {
#if DIGEST_AFTER == 1
        for (int idx = bx * 512 + tid; idx < SEQ * DM; idx += G * 512) { const int t = idx >> 11, c = idx & 2047; const bf16_t* pr = PROJ + (size_t)t * LDP;
            out[idx] = bf2f(pr[c]) + bf2f(pr[c + 2048]) + (c + 4096 < INC ? bf2f(pr[c + 4096]) : 0.f); }
#elif DIGEST_AFTER == 2
        for (int idx = bx * 512 + tid; idx < SEQ * DM; idx += G * 512) { const int t = idx >> 11, c = idx & 2047; float v;
            if (c < 1024) v = bf2f(CO[idx]);
            else v = 0.f;
            out[idx] = v; }
#else
        for (int idx = bx * 512 + tid; idx < SEQ * DM; idx += G * 512) out[idx] = bf2f(CO[idx]);
#endif
    }
#undef IN
#undef SEAM
}

extern "C" void kernel_launch(void* const* d_in, const int* in_sizes, int n_in, void* d_out, int out_size, void* d_ws, size_t ws_size, hipStream_t stream) {
    static int grid = 0;
    if (grid == 0) {
        if (n_in != 20 || out_size != SEQ * DM || ws_size < WS_END) { fprintf(stderr, "kernel_launch: unexpected shapes (n_in %d out %d ws %zu)\n", n_in, out_size, ws_size); grid = -1; return; }
        int dev = 0, cus = 0, per_cu = 0;
        (void)hipGetDevice(&dev); (void)hipDeviceGetAttribute(&cus, hipDeviceAttributeMultiprocessorCount, dev);
        if (hipFuncSetAttribute((const void*)mega_fwd, hipFuncAttributeMaxDynamicSharedMemorySize, LDS_BYTES) != hipSuccess) { fprintf(stderr, "kernel_launch: hipFuncSetAttribute failed\n"); grid = -1; return; }
        if (hipOccupancyMaxActiveBlocksPerMultiprocessor(&per_cu, (const void*)mega_fwd, 512, LDS_BYTES) != hipSuccess || per_cu < 1) { fprintf(stderr, "kernel_launch: occupancy query failed (%d)\n", per_cu); per_cu = 1; }
        (void)hipGetLastError();
        grid = cus * (per_cu > 1 ? 1 : per_cu);
        if (grid > 256) grid = 256;
    }
    if (grid < 0) return;
    if (hipMemsetAsync((char*)d_ws + WS_BAR, 0, 40960, stream) != hipSuccess) { fprintf(stderr, "kernel_launch: memset of the barrier words failed\n"); return; }
    Args a{};
    for (int i = 0; i < 20; ++i) a.in[i] = (const float*)d_in[i];
    a.out = (float*)d_out; a.ws = (unsigned char*)d_ws;
#if MK_LAUNCHES == 1
    a.ph_lo = 0; a.ph_hi = 12;
    void* kargs[] = {&a};
    hipError_t e = hipLaunchCooperativeKernel((const void*)mega_fwd, dim3(grid), dim3(512), kargs, LDS_BYTES, stream);
    if (e != hipSuccess) fprintf(stderr, "cooperative launch failed: %s (grid %d)\n", hipGetErrorString(e), grid);
#else
#ifdef DIGEST_AFTER
    for (int p = 0; p <= DIGEST_AFTER; ++p) { a.ph_lo = p; a.ph_hi = p + 1; hipLaunchKernelGGL(mega_fwd, dim3(grid), dim3(512), LDS_BYTES, stream, a); }
    a.ph_lo = 12; a.ph_hi = 13; hipLaunchKernelGGL(mega_fwd, dim3(grid), dim3(512), LDS_BYTES, stream, a);
#else
    for (int p = 0; p < 12; ++p) { a.ph_lo = p; a.ph_hi = p + 1; hipLaunchKernelGGL(mega_fwd, dim3(grid), dim3(512), LDS_BYTES, stream, a); }
#endif
#endif
}
```
